# Optimizing an MI355X kernel written in HIP

```python
import math
import jax, jax.numpy as jnp
from jax import lax
import numpy as np

D_MODEL = 1024
BATCH = 8
SEQ = 2048
DEPTH = 4

N_META = 16
CHUNK = 128
NORM_EPS = 1e-6

SSD_HEADS = 4
SSD_HEAD_DIM = 64
SSD_WIDTH = SSD_HEADS * SSD_HEAD_DIM
SSD_GROUPS = 2
SSD_STATE = 128
SSD_CONV = 4
SSD_CONV_CH = SSD_WIDTH + 2 * SSD_GROUPS * SSD_STATE
SSD_IN = SSD_WIDTH + SSD_CONV_CH + SSD_HEADS

RWKV_HEADS = 4
RWKV_HEAD_DIM = 64
RWKV_WIDTH = RWKV_HEADS * RWKV_HEAD_DIM
RWKV_DECAY_RANK = 64
RWKV_A_RANK = 64
RWKV_GATE_RANK = 128
RWKV_IN = 3 * RWKV_WIDTH + RWKV_DECAY_RANK + RWKV_A_RANK + RWKV_GATE_RANK
RWKV_GN_EPS = 64e-5

LRU_BLOCKS = 4
LRU_BLOCK_DIM = 64
LRU_WIDTH = LRU_BLOCKS * LRU_BLOCK_DIM
LRU_CONV = 4
LRU_C = 8.0
LRU_IN = 2 * LRU_WIDTH

RET_HEADS = 4
RET_QK_DIM = 32
RET_V_DIM = 64
RET_WIDTH = RET_HEADS * RET_V_DIM
RET_IN = 2 * RET_HEADS * RET_QK_DIM + 2 * RET_WIDTH
RET_GN_EPS = 1e-5
ROPE_BASE = 10000.0

MIX_IN = SSD_IN + RWKV_IN + LRU_IN + RET_IN
MIX_WIDTH = SSD_WIDTH + RWKV_WIDTH + LRU_WIDTH + RET_WIDTH
D_FF = -(-8 * D_MODEL // (3 * 256)) * 256

kernel_name = "hybrid_ssd_rwkv7_rglru_retention_trunk"


def split_last(x, sizes):
    idx = [int(s) for s in np.cumsum(sizes)[:-1]]
    return jnp.split(x, idx, axis=-1)


def rms_norm(x, w):
    x32 = x.astype(jnp.float32)
    y = x32 * lax.rsqrt(jnp.mean(x32 * x32, axis=-1, keepdims=True) + NORM_EPS)
    return (y * w.astype(jnp.float32)).astype(x.dtype)


def causal_depthwise_conv(x, w, b):
    K, C = w.shape
    y = lax.conv_general_dilated(x, w[:, None, :].astype(x.dtype), window_strides=(1,),
                                 padding=[(K - 1, 0)], dimension_numbers=('NWC', 'WIO', 'NWC'),
                                 feature_group_count=C)
    return y + b.astype(x.dtype)


def pad_front(x, n):
    return jnp.pad(x, [(0, 0), (n, 0)] + [(0, 0)] * (x.ndim - 2))


def segsum(a):
    L = a.shape[-1]
    cs = jnp.cumsum(a, axis=-1)
    diff = cs[..., :, None] - cs[..., None, :]
    mask = jnp.tril(jnp.ones((L, L), dtype=bool))
    return jnp.where(mask, diff, -jnp.inf)


def head_group_norm(y, eps):
    mu = jnp.mean(y, axis=-1, keepdims=True)
    var = jnp.mean(jnp.square(y - mu), axis=-1, keepdims=True)
    return (y - mu) * lax.rsqrt(var + eps)


def rope(x, pos):
    half = x.shape[-1] // 2
    freqs = ROPE_BASE ** (-jnp.arange(half, dtype=jnp.float32) / half)
    ang = pos.astype(jnp.float32)[:, None] * freqs[None, :]
    cos = jnp.cos(ang)[None, :, None, :]
    sin = jnp.sin(ang)[None, :, None, :]
    x1, x2 = x[..., :half], x[..., half:]
    return jnp.concatenate([x1 * cos - x2 * sin, x1 * sin + x2 * cos], axis=-1)


def ssd_chunked(x, a, b, c):
    Bsz, T, H, P = x.shape
    G = b.shape[2]
    nc = T // CHUNK
    b = jnp.repeat(b, H // G, axis=2).reshape(Bsz, nc, CHUNK, H, -1)
    c = jnp.repeat(c, H // G, axis=2).reshape(Bsz, nc, CHUNK, H, -1)
    x = x.reshape(Bsz, nc, CHUNK, H, P)
    a = a.reshape(Bsz, nc, CHUNK, H).transpose(0, 3, 1, 2)
    a_cs = jnp.cumsum(a, axis=-1)
    Lmat = jnp.exp(segsum(a))
    y_diag = jnp.einsum('bclhn,bcshn,bhcls,bcshp->bclhp', c, b, Lmat, x)
    decay_states = jnp.exp(a_cs[..., -1:] - a_cs)
    states = jnp.einsum('bclhn,bhcl,bclhp->bchpn', b, decay_states, x)
    states = jnp.pad(states, [(0, 0), (1, 0), (0, 0), (0, 0), (0, 0)])
    chunk_a = jnp.pad(a_cs[..., -1], [(0, 0), (0, 0), (1, 0)])
    decay_chunk = jnp.exp(segsum(chunk_a))
    entering = jnp.einsum('bhzc,bchpn->bzhpn', decay_chunk, states)[:, :-1]
    y_off = jnp.einsum('bclhn,bchpn,bhcl->bclhp', c, entering, jnp.exp(a_cs))
    return (y_diag + y_off).reshape(Bsz, T, H, P)


def ssd_mix(p, conv_w, conv_b, dt_bias, a_log, d_skip, norm_w):
    f32 = jnp.float32
    Bsz, T, _ = p.shape
    z, xbc, dt_raw = split_last(p, [SSD_WIDTH, SSD_CONV_CH, SSD_HEADS])
    xbc = jax.nn.silu(causal_depthwise_conv(xbc, conv_w, conv_b)).astype(f32)
    xs, bs, cs = split_last(xbc, [SSD_WIDTH, SSD_GROUPS * SSD_STATE, SSD_GROUPS * SSD_STATE])
    xs = xs.reshape(Bsz, T, SSD_HEADS, SSD_HEAD_DIM)
    bs = bs.reshape(Bsz, T, SSD_GROUPS, SSD_STATE)
    cs = cs.reshape(Bsz, T, SSD_GROUPS, SSD_STATE)
    dt = jax.nn.softplus(dt_raw.astype(f32) + dt_bias.astype(f32))
    A = -jnp.exp(a_log.astype(f32))
    pad = CHUNK - N_META
    y = ssd_chunked(pad_front(xs * dt[..., None], pad), pad_front(dt * A, pad),
                    pad_front(bs, pad), pad_front(cs, pad))[:, pad:]
    y = y + d_skip.astype(f32)[:, None] * xs
    y = y.reshape(Bsz, T, SSD_WIDTH) * jax.nn.silu(z.astype(f32))
    yg = y.reshape(Bsz, T, SSD_GROUPS, -1)
    yg = yg * lax.rsqrt(jnp.mean(yg * yg, axis=-1, keepdims=True) + NORM_EPS)
    return yg.reshape(Bsz, T, SSD_WIDTH) * norm_w.astype(f32)


def rwkv7_scan(r, w, k, v, kk, a):
    Bsz, T, H, N = r.shape

    def step(S, inp):
        r_t, w_t, k_t, v_t, kk_t, a_t = inp
        sa = jnp.einsum('bhvk,bhk->bhv', S, -kk_t)
        S = (S * w_t[:, :, None, :] + sa[..., None] * (kk_t * a_t)[:, :, None, :]
             + v_t[..., None] * k_t[:, :, None, :])
        return S, jnp.einsum('bhvk,bhk->bhv', S, r_t)

    xs = tuple(jnp.moveaxis(t, 1, 0) for t in (r, w, k, v, kk, a))
    _, y = lax.scan(step, jnp.zeros((Bsz, H, N, N), jnp.float32), xs)
    return jnp.moveaxis(y, 0, 1)


def rwkv7_mix(p, mu, w0, w2, a0, a2, g2, k_k, k_a, r_k, ln_w, ln_b):
    f32 = jnp.float32
    p = p.astype(f32)
    Bsz, T, _ = p.shape
    p_prev = jnp.pad(p, [(0, 0), (1, 0), (0, 0)])[:, :-1]
    p = p + (p_prev - p) * mu.astype(f32)
    r, k, v, w_lat, a_lat, g_lat = split_last(
        p, [RWKV_WIDTH, RWKV_WIDTH, RWKV_WIDTH, RWKV_DECAY_RANK, RWKV_A_RANK, RWKV_GATE_RANK])
    w = -jax.nn.softplus(-(w0.astype(f32) + jnp.tanh(w_lat) @ w2.astype(f32))) - 0.5
    decay = jnp.exp(-jnp.exp(w))
    a = jax.nn.sigmoid(a0.astype(f32) + a_lat @ a2.astype(f32))
    g = jax.nn.sigmoid(g_lat) @ g2.astype(f32)
    heads = lambda t: t.reshape(Bsz, T, RWKV_HEADS, RWKV_HEAD_DIM)
    kk = heads(k * k_k.astype(f32))
    kk = kk / jnp.maximum(jnp.sqrt(jnp.sum(kk * kk, axis=-1, keepdims=True)), 1e-12)
    k = k * (1.0 + (a - 1.0) * k_a.astype(f32))
    r_h, k_h, v_h, a_h = heads(r), heads(k), heads(v), heads(a)
    y = rwkv7_scan(r_h, heads(decay), k_h, v_h, kk, a_h)
    y = head_group_norm(y, RWKV_GN_EPS).reshape(Bsz, T, RWKV_WIDTH) * ln_w.astype(f32) + ln_b.astype(f32)
    bonus = jnp.sum(r_h * k_h * r_k.astype(f32), axis=-1, keepdims=True) * v_h
    y = y + bonus.reshape(Bsz, T, RWKV_WIDTH)
    return y * g


def rglru_mix(p, conv_w, conv_b, wa, ba, wx, bx, lam):
    f32 = jnp.float32
    Bsz, T, _ = p.shape
    xb, gb = split_last(p, [LRU_WIDTH, LRU_WIDTH])
    xc = causal_depthwise_conv(xb, conv_w, conv_b).astype(f32)
    xh = xc.reshape(Bsz, T, LRU_BLOCKS, LRU_BLOCK_DIM)
    r = jax.nn.sigmoid(jnp.einsum('btgi,gij->btgj', xh, wa.astype(f32)).reshape(Bsz, T, LRU_WIDTH) + ba.astype(f32))
    i = jax.nn.sigmoid(jnp.einsum('btgi,gij->btgj', xh, wx.astype(f32)).reshape(Bsz, T, LRU_WIDTH) + bx.astype(f32))
    log_a = -LRU_C * r * jax.nn.softplus(-lam.astype(f32))
    a = jnp.exp(log_a)
    u = jnp.sqrt(-jnp.expm1(2.0 * log_a)) * (i * xc)

    def combine(e1, e2):
        a1, b1 = e1
        a2, b2 = e2
        return a1 * a2, a2 * b1 + b2

    _, h = lax.associative_scan(combine, (a, u), axis=1)
    return h * jax.nn.gelu(gb.astype(f32), approximate=True)


def retention_mix(p, gn_w):
    f32 = jnp.float32
    p = p.astype(f32)
    Bsz, T, _ = p.shape
    qk = RET_HEADS * RET_QK_DIM
    q, k, v, g = split_last(p, [qk, qk, RET_WIDTH, RET_WIDTH])
    pos = jnp.arange(T)
    q = rope(q.reshape(Bsz, T, RET_HEADS, RET_QK_DIM), pos)
    k = rope(k.reshape(Bsz, T, RET_HEADS, RET_QK_DIM), pos) * (RET_QK_DIM ** -0.5)
    v = v.reshape(Bsz, T, RET_HEADS, RET_V_DIM)
    pad = CHUNK - N_META
    Tp = T + pad
    nc = Tp // CHUNK
    qc = pad_front(q, pad).reshape(Bsz, nc, CHUNK, RET_HEADS, RET_QK_DIM)
    kc = pad_front(k, pad).reshape(Bsz, nc, CHUNK, RET_HEADS, RET_QK_DIM)
    vc = pad_front(v, pad).reshape(Bsz, nc, CHUNK, RET_HEADS, RET_V_DIM)
    log_g = jnp.log1p(-jnp.exp2(-5.0 - jnp.arange(RET_HEADS, dtype=f32)))
    idx = jnp.arange(CHUNK)
    rel = idx[:, None] - idx[None, :]
    inner_decay = jnp.where(rel >= 0, jnp.exp(jnp.maximum(rel, 0)[None] * log_g[:, None, None]), 0.0)
    scores = jnp.einsum('bclhd,bcshd->bchls', qc, kc) * inner_decay
    y_inner = jnp.einsum('bchls,bcshe->bclhe', scores, vc)
    k_decay = jnp.exp((CHUNK - 1 - idx)[None, :] * log_g[:, None])
    kv = jnp.einsum('bcshd,hs,bcshe->bchde', kc, k_decay, vc)
    cidx = jnp.arange(nc)
    crel = cidx[:, None] - cidx[None, :] - 1
    cross_decay = jnp.where(crel >= 0, jnp.exp(jnp.maximum(crel, 0)[None] * (CHUNK * log_g)[:, None, None]), 0.0)
    R = jnp.einsum('hzc,bchde->bzhde', cross_decay, kv)
    q_decay = jnp.exp((idx + 1)[None, :] * log_g[:, None])
    y_cross = jnp.einsum('bclhd,bchde,hl->bclhe', qc, R, q_decay)
    y = (y_inner + y_cross).reshape(Bsz, Tp, RET_HEADS, RET_V_DIM)[:, pad:]
    y = head_group_norm(y, RET_GN_EPS).reshape(Bsz, T, RET_WIDTH) * gn_w.astype(f32)
    return y * jax.nn.silu(g)


def setup_inputs(seed: int = 0) -> dict:
    key = jax.random.key(seed)
    ks = iter(jax.random.split(key, 48))
    f32 = jnp.float32
    nrm = lambda shape, scale: jax.random.normal(next(ks), shape, f32) * scale
    unif = lambda shape, lo, hi: jax.random.uniform(next(ks), shape, f32, lo, hi)
    L = DEPTH
    x = nrm((BATCH, SEQ, D_MODEL), 1.0)
    meta_tokens = nrm((N_META, D_MODEL), 1.0)
    pre_mix_norm = 1.0 + nrm((L, D_MODEL), 0.02)
    post_mix_norm = 1.0 + nrm((L, D_MODEL), 0.02)
    pre_ffn_norm = 1.0 + nrm((L, D_MODEL), 0.02)
    post_ffn_norm = 1.0 + nrm((L, D_MODEL), 0.02)
    w_in = nrm((L, D_MODEL, MIX_IN), D_MODEL ** -0.5)
    w_out = nrm((L, MIX_WIDTH, D_MODEL), MIX_WIDTH ** -0.5)
    ssd_conv_w = nrm((L, SSD_CONV, SSD_CONV_CH), SSD_CONV ** -0.5)
    ssd_conv_b = nrm((L, SSD_CONV_CH), 0.02)
    dt = jnp.exp(unif((L, SSD_HEADS), math.log(1e-3), math.log(1e-1)))
    ssd_dt_bias = dt + jnp.log(-jnp.expm1(-dt))
    ssd_a_log = jnp.log(unif((L, SSD_HEADS), 1.0, 16.0))
    ssd_d = 1.0 + nrm((L, SSD_HEADS), 0.1)
    ssd_norm_w = 1.0 + nrm((L, SSD_WIDTH), 0.02)
    rwkv_mu = unif((L, RWKV_IN), 0.0, 1.0)
    ratio = jnp.linspace(0.0, 1.0, RWKV_WIDTH, dtype=f32)
    rwkv_w0 = (-6.5 + 5.0 * ratio ** 0.85)[None, :] + nrm((L, RWKV_WIDTH), 0.1)
    rwkv_w2 = nrm((L, RWKV_DECAY_RANK, RWKV_WIDTH), 0.1 * RWKV_DECAY_RANK ** -0.5)
    rwkv_a0 = nrm((L, RWKV_WIDTH), 0.1)
    rwkv_a2 = nrm((L, RWKV_A_RANK, RWKV_WIDTH), 0.1 * RWKV_A_RANK ** -0.5)
    rwkv_g2 = nrm((L, RWKV_GATE_RANK, RWKV_WIDTH), RWKV_GATE_RANK ** -0.5)
    rwkv_k_k = 0.85 + nrm((L, RWKV_WIDTH), 0.02)
    rwkv_k_a = 1.0 + nrm((L, RWKV_WIDTH), 0.02)
    rwkv_r_k = nrm((L, RWKV_HEADS, RWKV_HEAD_DIM), 0.1)
    rwkv_ln_w = 1.0 + nrm((L, RWKV_WIDTH), 0.02)
    rwkv_ln_b = nrm((L, RWKV_WIDTH), 0.02)
    lru_conv_w = nrm((L, LRU_CONV, LRU_WIDTH), LRU_CONV ** -0.5)
    lru_conv_b = nrm((L, LRU_WIDTH), 0.02)
    lru_wa = nrm((L, LRU_BLOCKS, LRU_BLOCK_DIM, LRU_BLOCK_DIM), LRU_BLOCK_DIM ** -0.5)
    lru_ba = nrm((L, LRU_WIDTH), 0.02)
    lru_wx = nrm((L, LRU_BLOCKS, LRU_BLOCK_DIM, LRU_BLOCK_DIM), LRU_BLOCK_DIM ** -0.5)
    lru_bx = nrm((L, LRU_WIDTH), 0.02)
    s = unif((L, LRU_WIDTH), 0.9, 0.999) ** (1.0 / LRU_C)
    lru_lambda = jnp.log(s) - jnp.log1p(-s)
    ret_gn_w = 1.0 + nrm((L, RET_WIDTH), 0.02)
    ffn_w_gate = nrm((L, D_MODEL, D_FF), D_MODEL ** -0.5)
    ffn_w_up = nrm((L, D_MODEL, D_FF), D_MODEL ** -0.5)
    ffn_w_down = nrm((L, D_FF, D_MODEL), D_FF ** -0.5)
    return {"x": x, "meta_tokens": meta_tokens, "pre_mix_norm": pre_mix_norm,
            "post_mix_norm": post_mix_norm, "pre_ffn_norm": pre_ffn_norm,
            "post_ffn_norm": post_ffn_norm, "w_in": w_in, "w_out": w_out,
            "ssd_conv_w": ssd_conv_w, "ssd_conv_b": ssd_conv_b, "ssd_dt_bias": ssd_dt_bias,
            "ssd_a_log": ssd_a_log, "ssd_d": ssd_d, "ssd_norm_w": ssd_norm_w,
            "rwkv_mu": rwkv_mu, "rwkv_w0": rwkv_w0, "rwkv_w2": rwkv_w2, "rwkv_a0": rwkv_a0,
            "rwkv_a2": rwkv_a2, "rwkv_g2": rwkv_g2, "rwkv_k_k": rwkv_k_k, "rwkv_k_a": rwkv_k_a,
            "rwkv_r_k": rwkv_r_k, "rwkv_ln_w": rwkv_ln_w, "rwkv_ln_b": rwkv_ln_b,
            "lru_conv_w": lru_conv_w, "lru_conv_b": lru_conv_b, "lru_wa": lru_wa,
            "lru_ba": lru_ba, "lru_wx": lru_wx, "lru_bx": lru_bx, "lru_lambda": lru_lambda,
            "ret_gn_w": ret_gn_w, "ffn_w_gate": ffn_w_gate, "ffn_w_up": ffn_w_up,
            "ffn_w_down": ffn_w_down}


def reference(x, meta_tokens, pre_mix_norm, post_mix_norm, pre_ffn_norm, post_ffn_norm,
              w_in, w_out, ssd_conv_w, ssd_conv_b, ssd_dt_bias, ssd_a_log, ssd_d, ssd_norm_w,
              rwkv_mu, rwkv_w0, rwkv_w2, rwkv_a0, rwkv_a2, rwkv_g2, rwkv_k_k, rwkv_k_a,
              rwkv_r_k, rwkv_ln_w, rwkv_ln_b, lru_conv_w, lru_conv_b, lru_wa, lru_ba,
              lru_wx, lru_bx, lru_lambda, ret_gn_w, ffn_w_gate, ffn_w_up, ffn_w_down):
    Bsz = x.shape[0]
    meta = jnp.broadcast_to(meta_tokens.astype(x.dtype)[None], (Bsz, N_META, x.shape[-1]))
    h = jnp.concatenate([meta, x], axis=1)
    for l in range(DEPTH):
        hn = rms_norm(h, pre_mix_norm[l])
        proj = hn @ w_in[l]
        p_ssd, p_rwkv, p_lru, p_ret = split_last(proj, [SSD_IN, RWKV_IN, LRU_IN, RET_IN])
        y = jnp.concatenate([
            ssd_mix(p_ssd, ssd_conv_w[l], ssd_conv_b[l], ssd_dt_bias[l], ssd_a_log[l], ssd_d[l], ssd_norm_w[l]),
            rwkv7_mix(p_rwkv, rwkv_mu[l], rwkv_w0[l], rwkv_w2[l], rwkv_a0[l], rwkv_a2[l], rwkv_g2[l],
                      rwkv_k_k[l], rwkv_k_a[l], rwkv_r_k[l], rwkv_ln_w[l], rwkv_ln_b[l]),
            rglru_mix(p_lru, lru_conv_w[l], lru_conv_b[l], lru_wa[l], lru_ba[l], lru_wx[l], lru_bx[l], lru_lambda[l]),
            retention_mix(p_ret, ret_gn_w[l]),
        ], axis=-1).astype(h.dtype)
        h = h + rms_norm(y @ w_out[l], post_mix_norm[l])
        hn = rms_norm(h, pre_ffn_norm[l])
        f = (jax.nn.silu(hn @ ffn_w_gate[l]) * (hn @ ffn_w_up[l])) @ ffn_w_down[l]
        h = h + rms_norm(f, post_ffn_norm[l])
    return h[:, N_META:]
```

```cpp
#include <hip/hip_runtime.h>
#include <hip/hip_bf16.h>
#include <hip/hip_cooperative_groups.h>
#include <cstdio>
#include <cstdint>
namespace cg = cooperative_groups;

#ifndef MULTI_LAUNCH
#define MULTI_LAUNCH 0
#endif

typedef unsigned short bf16_t;
using bf16x8 = __attribute__((ext_vector_type(8))) short;
using f32x4 = __attribute__((ext_vector_type(4))) float;

constexpr int D = 1024, NB = 8, SEQ = 2048, NMETA = 16, T = 2064, R = NB * T, NL = 4;
constexpr int RREAL = NB * SEQ;
constexpr int MIXIN = 3332, PJ = 3336, NIN_PAD = 3456, DFF = 2816;
constexpr int OFF_Z = 0, OFF_XBC = 256, OFF_DT = 1024, OFF_RW = 1028, OFF_LRU = 2052, OFF_RET = 2564;
constexpr float EPS = 1e-6f;

constexpr size_t WS_BAR = 0;
constexpr size_t WS_HMETA = 16384;
constexpr size_t WS_ROPE = WS_HMETA + 128 * 1024 * 4;
constexpr size_t WS_WA = 1048576;
constexpr size_t WS_WB = WS_WA + (size_t)5632 * 1024 * 2;
constexpr size_t WS_PROJ = WS_WB + (size_t)1024 * 2816 * 2;
constexpr size_t WS_Y = WS_PROJ + (size_t)R * PJ * 2;
constexpr size_t WS_SCR = WS_Y + (size_t)R * 1024 * 2;
constexpr size_t WS_RW = WS_SCR;
constexpr size_t WS_SS = WS_RW + (size_t)R * 1536 * 2;
constexpr size_t WS_LR = WS_SS + (size_t)R * 768 * 2;
constexpr size_t WS_RG = WS_LR + (size_t)R * 512 * 2;
constexpr size_t WS_RC = WS_RG + (size_t)R * 256 * 2;
constexpr size_t WS_SD = WS_RC + (size_t)R * 4 * 4;
constexpr size_t WS_END = WS_SD + (size_t)R * 4 * 4;
constexpr size_t WS_WO = WS_END;
constexpr size_t WS_TOTAL = WS_WO + (size_t)1024 * 1024 * 2;
constexpr size_t WS_TMP = WS_SCR;
static_assert((size_t)R * 1024 * 4 <= WS_END - WS_SCR, "tmp must fit in scratch");

struct Params {
  const float* in[36];
  float* out;
  char* ws;
};
typedef const __attribute__((address_space(4))) Params& CP;

__device__ __forceinline__ float bf2f(bf16_t v) { return __uint_as_float(((unsigned)v) << 16); }
typedef __bf16 hwbf16x2 __attribute__((ext_vector_type(2)));
typedef float hwf32x2 __attribute__((ext_vector_type(2)));
__device__ __forceinline__ unsigned pack2(float a, float b) {
  const hwf32x2 v = {a, b};
  const hwbf16x2 r = __builtin_convertvector(v, hwbf16x2);
  return __builtin_bit_cast(unsigned, r);
}
__device__ __forceinline__ bf16_t f2bf(float f) { return (bf16_t)(pack2(f, 0.f) & 0xffffu); }
__device__ __forceinline__ float lo2f(unsigned w) { return __uint_as_float(w << 16); }
__device__ __forceinline__ float hi2f(unsigned w) { return __uint_as_float(w & 0xffff0000u); }
__device__ __forceinline__ float sigmoidf_(float x) { return __builtin_amdgcn_rcpf(1.f + __expf(-x)); }
__device__ __forceinline__ float softplusf_(float x) { return fmaxf(x, 0.f) + log1pf(__expf(-fabsf(x))); }
__device__ __forceinline__ float siluf_(float x) { return x * __builtin_amdgcn_rcpf(1.f + __expf(-x)); }
__device__ __forceinline__ float wave_sum(float v) {
#pragma unroll
  for (int o = 32; o >= 1; o >>= 1) v += __shfl_xor(v, o, 64);
  return v;
}
__device__ __forceinline__ int tidx() { int t = threadIdx.x & 255; asm volatile("" : "+v"(t)); return t; }
__device__ __forceinline__ int tidx_full() { int t = threadIdx.x; asm volatile("" : "+v"(t)); return t; }
__device__ __forceinline__ int half_id() { int t = (int)(threadIdx.x >> 8); asm volatile("" : "+v"(t)); return __builtin_amdgcn_readfirstlane(t); }
__device__ __forceinline__ int bidx() { int t = blockIdx.x + half_id() * gridDim.x; asm volatile("" : "+s"(t)); return t; }
__device__ __forceinline__ int nvb() { return gridDim.x * 2; }
#define LAS3 __attribute__((address_space(3)))
__device__ __forceinline__ void half_barrier(char* smem_half) {
  const int h = half_id();
  LAS3 unsigned* cnt = (LAS3 unsigned*)(smem_half + (2 - h) * 65536 + 8 + h * 4);
  asm volatile("s_waitcnt lgkmcnt(0)" ::: "memory");
  if ((tidx() & 63) == 0) {
    const unsigned old = __hip_atomic_fetch_add(cnt, 1u, __ATOMIC_RELAXED, __HIP_MEMORY_SCOPE_WORKGROUP);
    const unsigned target = (old & ~3u) + 4u;
    while (__hip_atomic_load(cnt, __ATOMIC_RELAXED, __HIP_MEMORY_SCOPE_WORKGROUP) < target) __builtin_amdgcn_s_sleep(1);
  }
  asm volatile("" ::: "memory");
}
template <int CTRL>
__device__ __forceinline__ float dppf(float x) {
  return __int_as_float(__builtin_amdgcn_update_dpp(0, __float_as_int(x), CTRL, 0xF, 0xF, true));
}
__device__ __forceinline__ float allreduce4(float x) {
  x += dppf<0xB1>(x);
  x += dppf<0x4E>(x);
  return x;
}
__device__ __forceinline__ float allreduce16(float x) {
  x += dppf<0xB1>(x);
  x += dppf<0x4E>(x);
  x += dppf<0x141>(x);
  x += dppf<0x140>(x);
  return x;
}
__device__ __forceinline__ int rowof(int b, int t) { return t < NMETA ? RREAL + b * NMETA + t : b * SEQ + t - NMETA; }
__device__ __forceinline__ float* hrow_ptr(CP p, int row) {
  return row < RREAL ? p.out + (size_t)row * D : (float*)(p.ws + WS_HMETA) + (size_t)(row - RREAL) * D;
}

__device__ __forceinline__ int lds_byte(int r, int c) {
  int st = (r >> 4) * 2 + (c >> 5), rr = r & 15, cc = c & 31, ob = rr * 64 + cc * 2;
  return st * 1024 + (ob ^ (((ob >> 9) & 1) << 5));
}
__device__ __forceinline__ void stage_rc(int b, int& Rr, int& Cc) {
  int st = b / 1024, sb = b % 1024, swz = sb ^ (((sb >> 9) & 1) << 5);
  Rr = (st >> 1) * 16 + swz / 64;
  Cc = (st & 1) * 32 + (swz % 64) / 2;
}
typedef __attribute__((address_space(3))) unsigned lds_u32;
typedef __attribute__((address_space(1))) const unsigned glb_u32;

enum { EPI_BF16 = 0, EPI_F32 = 1, EPI_GLU = 2, EPI_PART = 3 };

template <int EPI>
__device__ __forceinline__ void gemm_tile256(const bf16_t* __restrict__ A, const bf16_t* __restrict__ Bt, int K, int nk, int brow, int bcol,
                             char* smem, void* outp, int ldo, int nvalid) {
  const int tid = tidx_full(), wid = tid >> 6, lane = tid & 63, wr = wid >> 2, wc = wid & 3, fr = lane & 15, fq = lane >> 4;
  f32x4 acc[8][4];
#pragma unroll
  for (int m = 0; m < 8; ++m)
#pragma unroll
    for (int n = 0; n < 4; ++n) acc[m][n] = f32x4{0.f, 0.f, 0.f, 0.f};
  const bf16_t* Ab = A + (size_t)brow * K;
  const bf16_t* Bb = Bt + (size_t)bcol * K;
  int soff[4];
#pragma unroll
  for (int i = 0; i < 4; ++i) {
    int r, c;
    stage_rc(tid * 16 + i * 8192, r, c);
    soff[i] = r * K + c;
  }
  auto stage = [&](int buf, int kt) {
    char* sa = smem + buf * 65536;
    char* sb = sa + 32768;
#pragma unroll
    for (int i = 0; i < 4; ++i) {
      const int b = tid * 16 + i * 8192;
      __builtin_amdgcn_global_load_lds((glb_u32*)(Ab + soff[i] + kt * 64), (lds_u32*)(sa + b), 16, 0, 0);
      __builtin_amdgcn_global_load_lds((glb_u32*)(Bb + soff[i] + kt * 64), (lds_u32*)(sb + b), 16, 0, 0);
    }
  };
  stage(0, 0);
  for (int kt = 0; kt < nk; ++kt) {
    asm volatile("s_waitcnt vmcnt(0)" ::: "memory");
    __syncthreads();
    if (kt + 1 < nk) stage((kt + 1) & 1, kt + 1);
    const char* sa = smem + (kt & 1) * 65536;
    const char* sb = sa + 32768;
#pragma unroll
    for (int k = 0; k < 2; ++k) {
      bf16x8 af[8], bfr[4];
#pragma unroll
      for (int m = 0; m < 8; ++m) af[m] = *reinterpret_cast<const bf16x8*>(sa + lds_byte(wr * 128 + m * 16 + fr, k * 32 + fq * 8));
#pragma unroll
      for (int n = 0; n < 4; ++n) bfr[n] = *reinterpret_cast<const bf16x8*>(sb + lds_byte(wc * 64 + n * 16 + fr, k * 32 + fq * 8));
      __builtin_amdgcn_sched_barrier(0);
#pragma unroll
      for (int m = 0; m < 8; ++m)
#pragma unroll
        for (int n = 0; n < 4; ++n) acc[m][n] = __builtin_amdgcn_mfma_f32_16x16x32_bf16(bfr[n], af[m], acc[m][n], 0, 0, 0);
      __builtin_amdgcn_sched_barrier(0);
    }
  }
  __syncthreads();
  if (EPI == EPI_BF16) {
    bf16_t* O = (bf16_t*)outp;
#pragma unroll
    for (int m = 0; m < 8; ++m) {
      const int row = brow + wr * 128 + m * 16 + fr;
#pragma unroll
      for (int n = 0; n < 4; ++n) {
        const int col = bcol + wc * 64 + n * 16 + fq * 4;
        if (col < nvalid && row < R)
          *reinterpret_cast<uint2*>(O + (size_t)row * ldo + col) = make_uint2(pack2(acc[m][n][0], acc[m][n][1]), pack2(acc[m][n][2], acc[m][n][3]));
      }
    }
  } else if (EPI == EPI_F32) {
    float* O = (float*)outp;
#pragma unroll
    for (int m = 0; m < 8; ++m) {
      const int row = brow + wr * 128 + m * 16 + fr;
#pragma unroll
      for (int n = 0; n < 4; ++n) {
        const int col = bcol + wc * 64 + n * 16 + fq * 4;
        if (row < R) *reinterpret_cast<float4*>(O + (size_t)row * ldo + col) = make_float4(acc[m][n][0], acc[m][n][1], acc[m][n][2], acc[m][n][3]);
      }
    }
  } else if (EPI == EPI_PART) {
    float* O = (float*)outp;
    if (wr == 0) {
#pragma unroll
      for (int m = 0; m < 8; ++m)
#pragma unroll
        for (int n = 0; n < 4; ++n) {
          const int col = bcol + wc * 64 + n * 16 + fq * 4;
          *reinterpret_cast<float4*>(O + (size_t)(m * 16 + fr) * ldo + col) = make_float4(acc[m][n][0], acc[m][n][1], acc[m][n][2], acc[m][n][3]);
        }
    }
  } else {
    bf16_t* O = (bf16_t*)outp;
#pragma unroll
    for (int m = 0; m < 8; ++m) {
      const int row = brow + wr * 128 + m * 16 + fr;
#pragma unroll
      for (int n = 0; n < 2; ++n) {
        const int col = (bcol >> 8) * 128 + wc * 32 + n * 16 + fq * 4;
        float a[4];
#pragma unroll
        for (int j = 0; j < 4; ++j) a[j] = siluf_(acc[m][n][j]) * acc[m][n + 2][j];
        if (row < R) *reinterpret_cast<uint2*>(O + (size_t)row * ldo + col) = make_uint2(pack2(a[0], a[1]), pack2(a[2], a[3]));
      }
    }
  }
}

template <int EPI>
__device__ __forceinline__ void gemm_tile8p(const bf16_t* __restrict__ Ag, const bf16_t* __restrict__ Bg, int K, int nt, int brow, int bcol,
                                            char* smem, void* outp, int ldo, int nvalid, int rowoff, int rowlim,
                                            bool prestaged = false, bool have_next = false, int nbrow = 0, int nbcol = 0) {
  constexpr int HT = 128 * 64, HALF = 128;
  bf16_t* shm = (bf16_t*)smem;
  const int tid = tidx_full();
  const int wid = tid >> 6, lane = tid & 63, wr = wid >> 2, wc = wid & 3, fr = lane & 15, fq = lane >> 4;
  int goff0;
  { int r, c; stage_rc(tid * 16, r, c); goff0 = r * K + c; }
#define SA8(b, h) (shm + ((b) * 2 + (h)) * HT)
#define SB8(b, h) (shm + (4 + (b) * 2 + (h)) * HT)
#define STAGE8(P, BASE, br, kt) do { const bf16_t* _g = (BASE) + (size_t)(br) * K + (kt) * 64; \
    _Pragma("unroll") for (int _i = 0; _i < 2; ++_i) \
      __builtin_amdgcn_global_load_lds((glb_u32*)(_g + goff0 + _i * 64 * K), (lds_u32*)((char*)(P) + tid * 16 + _i * 8192), 16, 0, 0); } while (0)
#define LDA8(dst, b, h) _Pragma("unroll") for (int m = 0; m < 4; ++m) _Pragma("unroll") for (int k = 0; k < 2; ++k) \
    dst[m][k] = *reinterpret_cast<const bf16x8*>((const char*)SA8(b, h) + lds_byte(wr * 64 + m * 16 + fr, k * 32 + fq * 8))
#define LDB8(dst, b, h) _Pragma("unroll") for (int n = 0; n < 2; ++n) _Pragma("unroll") for (int k = 0; k < 2; ++k) \
    dst[n][k] = *reinterpret_cast<const bf16x8*>((const char*)SB8(b, h) + lds_byte(wc * 32 + n * 16 + fr, k * 32 + fq * 8))
#define MMA8(ai, bj, Af, Bf) do { __builtin_amdgcn_s_setprio(1); \
    _Pragma("unroll") for (int m = 0; m < 4; ++m) _Pragma("unroll") for (int n = 0; n < 2; ++n) _Pragma("unroll") for (int k = 0; k < 2; ++k) \
      acc[ai][bj][m][n] = __builtin_amdgcn_mfma_f32_16x16x32_bf16(Af[m][k], Bf[n][k], acc[ai][bj][m][n], 0, 0, 0); \
    __builtin_amdgcn_s_setprio(0); } while (0)
#define WAIT_V8(n) asm volatile("s_waitcnt vmcnt(" #n ")" ::: "memory")
#define WAIT_L8(n) asm volatile("s_waitcnt lgkmcnt(" #n ")" ::: "memory")
#define BAR8 __builtin_amdgcn_s_barrier()
#define SCHED8 __builtin_amdgcn_sched_barrier(0)
  f32x4 acc[2][2][4][2];
#pragma unroll
  for (int a = 0; a < 2; ++a)
#pragma unroll
    for (int b = 0; b < 2; ++b)
#pragma unroll
      for (int m = 0; m < 4; ++m)
#pragma unroll
        for (int n = 0; n < 2; ++n) acc[a][b][m][n] = f32x4{0.f, 0.f, 0.f, 0.f};
  bf16x8 At[4][2], B0[2][2], B1[2][2];
  if (!prestaged) {
    STAGE8(SB8(0, 0), Bg, bcol, 0); STAGE8(SA8(0, 0), Ag, brow, 0);
    STAGE8(SB8(0, 1), Bg, bcol + HALF, 0); STAGE8(SA8(0, 1), Ag, brow + HALF, 0);
  }
  if (wr == 1) BAR8;
  WAIT_V8(4); BAR8;
  STAGE8(SB8(1, 0), Bg, bcol, 1); STAGE8(SA8(1, 0), Ag, brow, 1); STAGE8(SB8(1, 1), Bg, bcol + HALF, 1);
  WAIT_V8(6); BAR8;
  for (int t = 0; t < nt - 2; t += 2) {
    LDB8(B0, 0, 0); SCHED8; LDA8(At, 0, 0); STAGE8(SA8(1, 1), Ag, brow + HALF, t + 1);
    WAIT_L8(8); BAR8; WAIT_L8(0); MMA8(0, 0, At, B0); BAR8; SCHED8;
    LDB8(B1, 0, 1); STAGE8(SB8(0, 0), Bg, bcol, t + 2);
    BAR8; WAIT_L8(0); MMA8(0, 1, At, B1); BAR8;
    LDA8(At, 0, 1); STAGE8(SA8(0, 0), Ag, brow, t + 2);
    BAR8; WAIT_L8(0); MMA8(1, 0, At, B0); BAR8; SCHED8;
    STAGE8(SB8(0, 1), Bg, bcol + HALF, t + 2);
    WAIT_V8(6); BAR8; MMA8(1, 1, At, B1); BAR8;
    LDB8(B0, 1, 0); SCHED8; LDA8(At, 1, 0); STAGE8(SA8(0, 1), Ag, brow + HALF, t + 2);
    WAIT_L8(8); BAR8; WAIT_L8(0); MMA8(0, 0, At, B0); BAR8; SCHED8;
    LDB8(B1, 1, 1); STAGE8(SB8(1, 0), Bg, bcol, t + 3);
    BAR8; WAIT_L8(0); MMA8(0, 1, At, B1); BAR8;
    LDA8(At, 1, 1); STAGE8(SA8(1, 0), Ag, brow, t + 3);
    BAR8; WAIT_L8(0); MMA8(1, 0, At, B0); BAR8; SCHED8;
    STAGE8(SB8(1, 1), Bg, bcol + HALF, t + 3);
    WAIT_V8(6); BAR8; MMA8(1, 1, At, B1); BAR8;
  }
  { LDB8(B0, 0, 0); LDA8(At, 0, 0); STAGE8(SA8(1, 1), Ag, brow + HALF, nt - 1);
    BAR8; WAIT_L8(0); MMA8(0, 0, At, B0); BAR8;
    LDB8(B1, 0, 1); BAR8; WAIT_L8(0); MMA8(0, 1, At, B1); BAR8;
    LDA8(At, 0, 1); WAIT_V8(4); BAR8; WAIT_L8(0); MMA8(1, 0, At, B0); MMA8(1, 1, At, B1); BAR8; }
  { LDB8(B0, 1, 0); LDA8(At, 1, 0); WAIT_V8(2); BAR8; WAIT_L8(0); MMA8(0, 0, At, B0); BAR8;
    LDB8(B1, 1, 1); WAIT_V8(0); BAR8; WAIT_L8(0); MMA8(0, 1, At, B1); BAR8;
    LDA8(At, 1, 1); BAR8; WAIT_L8(0); MMA8(1, 0, At, B0); MMA8(1, 1, At, B1); BAR8; }
  if (wr == 0) BAR8;
  if (have_next) {
    STAGE8(SB8(0, 0), Bg, nbcol, 0); STAGE8(SA8(0, 0), Ag, nbrow, 0);
    STAGE8(SB8(0, 1), Bg, nbcol + HALF, 0); STAGE8(SA8(0, 1), Ag, nbrow + HALF, 0);
  }
#pragma unroll
  for (int ai = 0; ai < 2; ++ai)
#pragma unroll
    for (int m = 0; m < 4; ++m)
#pragma unroll
      for (int j = 0; j < 4; ++j) {
        const int rl = ai * HALF + wr * 64 + m * 16 + fq * 4 + j;
        const size_t orow = (size_t)(rowoff + rl) * ldo;
        if (EPI == EPI_GLU) {
#pragma unroll
          for (int n = 0; n < 2; ++n) {
            const int col = (bcol >> 8) * 128 + wc * 32 + n * 16 + fr;
            const float g = acc[ai][0][m][n][j], u = acc[ai][1][m][n][j];
            if (rl < rowlim) ((bf16_t*)outp)[orow + col] = f2bf(siluf_(g) * u);
          }
        } else {
#pragma unroll
          for (int bj = 0; bj < 2; ++bj)
#pragma unroll
            for (int n = 0; n < 2; ++n) {
              const int col = bcol + bj * HALF + wc * 32 + n * 16 + fr;
              const float v = acc[ai][bj][m][n][j];
              if (EPI == EPI_BF16) { if (rl < rowlim && col < nvalid) ((bf16_t*)outp)[orow + col] = f2bf(v); }
              else { if (rl < rowlim) ((float*)outp)[orow + col] = v; }
            }
        }
        __builtin_amdgcn_sched_barrier(0);
      }
#undef SA8
#undef SB8
#undef STAGE8
#undef LDA8
#undef LDB8
#undef MMA8
#undef WAIT_V8
#undef WAIT_L8
#undef BAR8
#undef SCHED8
  if (!have_next) __syncthreads();
}

template <int EPI>
__device__ __forceinline__ void gemm_phase256(const bf16_t* A, const bf16_t* Bt, int K, int NT, char* smem, void* outp, int ldo, int nvalid) {
  constexpr int TM = (R + 255) / 256;
  const int ntiles = TM * NT;
  const int nb = gridDim.x;
  const int xcd = blockIdx.x & 7, slot = blockIdx.x >> 3, per = nb >> 3;
  auto tile_of = [&](int it, int& tm, int& tn) -> bool {
    if (it * nb >= ntiles) return false;
    const int k = (it * 8 + xcd) * per + slot;
    if (k >= ntiles) return false;
    const int panel = k / (TM * 8);
    const int w = min(8, NT - panel * 8);
    const int idx = k - panel * TM * 8;
    tm = idx / w; tn = panel * 8 + idx % w;
    return true;
  };
  int tm = 0, tn = 0, ntm = 0, ntn = 0;
  bool cur = tile_of(0, tm, tn), pre = false;
  for (int it = 0; cur; ++it) {
    const bool nxt = tile_of(it + 1, ntm, ntn);
    gemm_tile8p<EPI>(A, Bt, K, K >> 6, tm * 256, tn * 256, smem, outp, ldo, nvalid, tm * 256, R - tm * 256, pre, nxt, ntm * 256, ntn * 256);
    pre = nxt; cur = nxt; tm = ntm; tn = ntn;
  }
}

constexpr size_t WS_PART = WS_TMP + (size_t)68 * 1024 * 1024;
static_assert(WS_PART + (size_t)11 * 128 * 1024 * 4 <= WS_END, "partial slabs must fit");
template <int K>
__device__ __forceinline__ void gemm_phase_n1024(CP p, const bf16_t* A, const bf16_t* Bt, char* smem, float* outp) {
  const int nb = gridDim.x;
  const int xcd = blockIdx.x & 7, slot = blockIdx.x >> 3, per = nb >> 3;
  const int nkc = K >> 8;
  const int nmain = 256, nitems = nmain + 4 * nkc;
  float* part = (float*)(p.ws + WS_PART);
  for (int it = 0; it * nb < nitems; ++it) {
    int id = it * nb + blockIdx.x;
    if ((it + 1) * nb <= nmain) id = (it * 8 + xcd) * per + slot;
    if (id >= nitems) break;
    const bf16_t* Ai = A; const bf16_t* Bi = Bt; float* Oi = outp;
    int nti = K >> 6, brow = (id >> 2) * 256, bcol = (id & 3) * 256, rowoff = brow, rowlim = 256;
    if (id >= nmain) {
      const int pid = id - nmain, kc = pid >> 2;
      Ai = A + kc * 256; Bi = Bt + kc * 256; Oi = part + (size_t)kc * 128 * 1024;
      nti = 4; brow = RREAL; bcol = (pid & 3) * 256; rowoff = 0; rowlim = 128;
    }
    gemm_tile8p<EPI_F32>(Ai, Bi, K, nti, brow, bcol, smem, Oi, D, D, rowoff, rowlim);
  }
}

__device__ __forceinline__ int map_n(int n, int maptype) {
  if (maptype == 0) return n;
  return (n >> 7) * 256 + (n & 127) + (maptype == 2 ? 128 : 0);
}
__device__ __forceinline__ void conv_tile(const float* __restrict__ src, bf16_t* __restrict__ dst, int K, int N, int k0, int n0, int maptype,
                          char* smem) {
  bf16_t* tile = (bf16_t*)smem;
  const int tid = tidx();
  half_barrier(smem);
#pragma unroll
  for (int i = 0; i < 4; ++i) {
    const int idx = tid + i * 256, k = idx >> 4, c4 = idx & 15, n = n0 + c4 * 4;
    float4 v = make_float4(0.f, 0.f, 0.f, 0.f);
    if (n < N) v = *reinterpret_cast<const float4*>(src + (size_t)(k0 + k) * N + n);
    tile[(c4 * 4 + 0) * 72 + k] = f2bf(v.x);
    tile[(c4 * 4 + 1) * 72 + k] = f2bf(v.y);
    tile[(c4 * 4 + 2) * 72 + k] = f2bf(v.z);
    tile[(c4 * 4 + 3) * 72 + k] = f2bf(v.w);
  }
  half_barrier(smem);
#pragma unroll
  for (int i = 0; i < 2; ++i) {
    const int idx = tid + i * 256, n = idx >> 3, kc = idx & 7;
    uint4 v = *reinterpret_cast<const uint4*>(tile + n * 72 + kc * 8);
    *reinterpret_cast<uint4*>(dst + (size_t)map_n(n0 + n, maptype) * K + k0 + kc * 8) = v;
  }
}
__device__ __forceinline__ void conv_matrix(const float* src, bf16_t* dst, int K, int N, int Npad, int maptype, char* smem, int start, int stride) {
  const int nkt = K / 64, nnt = Npad / 64;
  for (int id = start; id < nkt * nnt; id += stride) conv_tile(src, dst, K, N, (id % nkt) * 64, (id / nkt) * 64, maptype, smem);
}

__device__ __forceinline__ void rowwise_phase(CP p, int mode, const float* wpost, const float* wpre, bool write_hn, int nparts) {
  const int tid_ = tidx(); const int lane = tid_ & 63, gw = bidx() * 4 + (tid_ >> 6), nw = nvb() * 4;
  const float* tmp = (const float*)(p.ws + WS_TMP);
  bf16_t* hn = (bf16_t*)(p.ws + WS_Y);
  float4 wpo[4], wpr[4];
#pragma unroll
  for (int q = 0; q < 4; ++q) {
    wpo[q] = (mode != 0) ? *reinterpret_cast<const float4*>(wpost + q * 256 + lane * 4) : make_float4(0.f, 0.f, 0.f, 0.f);
    wpr[q] = write_hn ? *reinterpret_cast<const float4*>(wpre + q * 256 + lane * 4) : make_float4(0.f, 0.f, 0.f, 0.f);
  }
  float4 tv[4], hv[4], tvn[4], hvn[4], tvm[4], hvm[4];
  auto loadrow = [&](int row, float4 (&t)[4], float4 (&h)[4]) {
    if (mode == 0) {
      const float* src = row < RREAL ? p.in[0] + (size_t)row * D : p.in[1] + (size_t)((row - RREAL) & 15) * D;
#pragma unroll
      for (int q = 0; q < 4; ++q) { h[q] = *reinterpret_cast<const float4*>(src + q * 256 + lane * 4); t[q] = make_float4(0.f, 0.f, 0.f, 0.f); }
    } else {
      const float* hr = hrow_ptr(p, row);
#pragma unroll
      for (int q = 0; q < 4; ++q) {
        if (row < RREAL) {
          t[q] = *reinterpret_cast<const float4*>(tmp + (size_t)row * D + q * 256 + lane * 4);
        } else {
          const float* pp = (const float*)(p.ws + WS_PART) + (size_t)(row - RREAL) * D + q * 256 + lane * 4;
          float4 a = *reinterpret_cast<const float4*>(pp);
          for (int kc = 1; kc < nparts; ++kc) {
            const float4 c = *reinterpret_cast<const float4*>(pp + (size_t)kc * 128 * 1024);
            a.x += c.x; a.y += c.y; a.z += c.z; a.w += c.w;
          }
          t[q] = a;
        }
        h[q] = *reinterpret_cast<const float4*>(hr + q * 256 + lane * 4);
      }
    }
  };
  if (gw < R) loadrow(gw, tv, hv);
  if (gw + nw < R) loadrow(gw + nw, tvn, hvn);
  for (int row = gw; row < R; row += nw) {
    if (row + 2 * nw < R) loadrow(row + 2 * nw, tvm, hvm);
    float* hr = hrow_ptr(p, row);
    if (mode != 0) {
      float ss = 0.f;
#pragma unroll
      for (int q = 0; q < 4; ++q) ss += tv[q].x * tv[q].x + tv[q].y * tv[q].y + tv[q].z * tv[q].z + tv[q].w * tv[q].w;
      ss = wave_sum(ss);
      const float rs = rsqrtf(ss * (1.f / D) + EPS);
#pragma unroll
      for (int q = 0; q < 4; ++q) {
        hv[q].x += tv[q].x * rs * wpo[q].x;
        hv[q].y += tv[q].y * rs * wpo[q].y;
        hv[q].z += tv[q].z * rs * wpo[q].z;
        hv[q].w += tv[q].w * rs * wpo[q].w;
      }
    }
#pragma unroll
    for (int q = 0; q < 4; ++q) *reinterpret_cast<float4*>(hr + q * 256 + lane * 4) = hv[q];
    if (write_hn) {
      float ss = 0.f;
#pragma unroll
      for (int q = 0; q < 4; ++q) ss += hv[q].x * hv[q].x + hv[q].y * hv[q].y + hv[q].z * hv[q].z + hv[q].w * hv[q].w;
      ss = wave_sum(ss);
      const float rs = rsqrtf(ss * (1.f / D) + EPS);
#pragma unroll
      for (int q = 0; q < 4; ++q) {
        uint2 o;
        o.x = pack2(hv[q].x * rs * wpr[q].x, hv[q].y * rs * wpr[q].y);
        o.y = pack2(hv[q].z * rs * wpr[q].z, hv[q].w * rs * wpr[q].w);
        *reinterpret_cast<uint2*>(hn + (size_t)row * D + q * 256 + lane * 4) = o;
      }
    }
#pragma unroll
    for (int q = 0; q < 4; ++q) { tv[q] = tvn[q]; hv[q] = hvn[q]; tvn[q] = tvm[q]; hvn[q] = hvm[q]; }
  }
}

constexpr size_t WS_W2T = WS_WA - 196608;
constexpr size_t WS_A2T = WS_W2T + 32768;
constexpr size_t WS_G2T = WS_A2T + 32768;
constexpr size_t WS_WAT = WS_G2T + 65536;
constexpr size_t WS_WXT = WS_WAT + 32768;
static_assert(WS_W2T >= WS_ROPE + (size_t)T * 16 * 8, "small weights overlap rope");
constexpr int LSTR = 264;

constexpr int PMS = 516;
__device__ __forceinline__ float tanh_fast(float x) { return 1.f - 2.f * __builtin_amdgcn_rcpf(1.f + __expf(2.f * x)); }
__device__ __forceinline__ float softplus_fast(float x) { return fmaxf(x, 0.f) + __logf(1.f + __expf(-fabsf(x))); }
__device__ __forceinline__ uint2 ld_u2(const bf16_t* q) { return *reinterpret_cast<const uint2*>(q); }

__device__ __forceinline__ void prep_unit(CP p, int l, int u, char* smem) {
  float* pm = (float*)smem;
  bf16_t* latA = (bf16_t*)(smem + 16 * PMS * 4);
  bf16_t* xcA = latA + 16 * LSTR;
  const int tid = tidx(), lane = tid & 63, wid = tid >> 6, fr = lane & 15, fq = lane >> 4;
  const int b = u / 129, t0 = (u % 129) * 16;
  const int r0 = rowof(b, t0);
  const bf16_t* proj = (const bf16_t*)(p.ws + WS_PROJ);
  bf16_t* RW = (bf16_t*)(p.ws + WS_RW);
  bf16_t* SS = (bf16_t*)(p.ws + WS_SS);
  bf16_t* LR = (bf16_t*)(p.ws + WS_LR);
  bf16_t* RG = (bf16_t*)(p.ws + WS_RG);
  float* RC = (float*)(p.ws + WS_RC);
  float* SD = (float*)(p.ws + WS_SD);
  const int rm1 = (t0 > 0) ? rowof(b, t0 - 1) : 0, rm2 = (t0 > 0) ? rowof(b, t0 - 2) : 0, rm3 = (t0 > 0) ? rowof(b, t0 - 3) : 0;
  const float pz = (t0 > 0) ? 1.f : 0.f;
  half_barrier(smem);
  unsigned ra[2][17];
  unsigned rc[3][19];
  int coff[3];
#pragma unroll
  for (int q = 0; q < 2; ++q) {
    const int col = 2 * tid + q * 512;
    ra[q][0] = *reinterpret_cast<const unsigned*>(proj + (size_t)rm1 * PJ + OFF_RW + col);
#pragma unroll
    for (int tt = 0; tt < 16; ++tt) ra[q][1 + tt] = *reinterpret_cast<const unsigned*>(proj + (size_t)(r0 + tt) * PJ + OFF_RW + col);
  }
#pragma unroll
  for (int q = 0; q < 3; ++q) {
    const bool is_lru = (q == 2);
    const int pr = is_lru ? (tid & 127) : ((tid + q * 256) % 384);
    coff[q] = (is_lru ? OFF_LRU : OFF_XBC) + 2 * pr;
    rc[q][0] = *reinterpret_cast<const unsigned*>(proj + (size_t)rm3 * PJ + coff[q]);
    rc[q][1] = *reinterpret_cast<const unsigned*>(proj + (size_t)rm2 * PJ + coff[q]);
    rc[q][2] = *reinterpret_cast<const unsigned*>(proj + (size_t)rm1 * PJ + coff[q]);
#pragma unroll
    for (int tt = 0; tt < 16; ++tt) rc[q][3 + tt] = *reinterpret_cast<const unsigned*>(proj + (size_t)(r0 + tt) * PJ + coff[q]);
  }
  const bf16_t dtraw = proj[(size_t)(r0 + ((tid >> 2) & 15)) * PJ + OFF_DT + (tid & 3)];
  {
    const float* mu = p.in[14] + l * 1024;
#pragma unroll
    for (int q = 0; q < 2; ++q) {
      const int col = 2 * tid + q * 512;
      const float2 m = *reinterpret_cast<const float2*>(mu + col);
      const unsigned pw = ra[q][0];
      float p0 = pz * lo2f(pw), p1 = pz * hi2f(pw);
#pragma unroll
      for (int tt = 0; tt < 16; ++tt) {
        const unsigned cw_ = ra[q][1 + tt];
        const float c0 = lo2f(cw_), c1 = hi2f(cw_);
        const float v0 = c0 + (p0 - c0) * m.x, v1 = c1 + (p1 - c1) * m.y;
        p0 = c0; p1 = c1;
        if (q == 0) {
          *reinterpret_cast<float2*>(pm + tt * PMS + col) = make_float2(v0, v1);
        } else if (tid < 128) {
          *reinterpret_cast<unsigned*>(RW + (size_t)(r0 + tt) * 1536 + 1280 + 2 * tid) = pack2(v0, v1);
        } else {
          const int i = 2 * (tid - 128);
          float a0, a1;
          if (i < 64) { a0 = tanh_fast(v0); a1 = tanh_fast(v1); }
          else if (i < 128) { a0 = v0; a1 = v1; }
          else { a0 = sigmoidf_(v0); a1 = sigmoidf_(v1); }
          *reinterpret_cast<unsigned*>(latA + tt * LSTR + i) = pack2(a0, a1);
        }
      }
    }
  }
  {
#pragma unroll
    for (int q = 0; q < 3; ++q) {
      const bool is_lru = (q == 2);
      const int pr = is_lru ? tid : tid + q * 256;
      const bool act = is_lru ? (tid < 128) : (pr < 384);
      if (act) {
        const int ch = 2 * pr;
        const int C = is_lru ? 256 : 768;
        const float* cw = is_lru ? (p.in[25] + l * 4 * 256) : (p.in[8] + l * 4 * 768);
        const float2 cb = *reinterpret_cast<const float2*>((is_lru ? p.in[26] + l * 256 : p.in[9] + l * 768) + ch);
        const float2 w0 = *reinterpret_cast<const float2*>(cw + ch), w1 = *reinterpret_cast<const float2*>(cw + C + ch);
        const float2 w2 = *reinterpret_cast<const float2*>(cw + 2 * C + ch), w3 = *reinterpret_cast<const float2*>(cw + 3 * C + ch);
        const unsigned u0 = rc[q][0], u1 = rc[q][1], u2 = rc[q][2];
        float x0a = pz * lo2f(u0), x0b = pz * hi2f(u0), x1a = pz * lo2f(u1), x1b = pz * hi2f(u1), x2a = pz * lo2f(u2), x2b = pz * hi2f(u2);
#pragma unroll
        for (int tt = 0; tt < 16; ++tt) {
          const unsigned u3 = rc[q][3 + tt];
          const float x3a = lo2f(u3), x3b = hi2f(u3);
          const float ya = cb.x + w0.x * x0a + w1.x * x1a + w2.x * x2a + w3.x * x3a;
          const float yb = cb.y + w0.y * x0b + w1.y * x1b + w2.y * x2b + w3.y * x3b;
          if (is_lru) *reinterpret_cast<unsigned*>(xcA + tt * LSTR + ch) = pack2(ya, yb);
          else *reinterpret_cast<unsigned*>(SS + (size_t)(r0 + tt) * 768 + ch) = pack2(siluf_(ya), siluf_(yb));
          x0a = x1a; x0b = x1b; x1a = x2a; x1b = x2b; x2a = x3a; x2b = x3b;
        }
      }
    }
    if (tid < 64) {
      const int tt = tid >> 2, hh = tid & 3;
      const float v = bf2f(dtraw) + p.in[10][l * 4 + hh];
      SD[(size_t)(r0 + tt) * 4 + hh] = softplus_fast(v);
    }
  }
  half_barrier(smem);
  f32x4 accw[4], acca[4], accg[4], accr[4], acci[4];
#pragma unroll
  for (int mf = 0; mf < 4; ++mf) {
    accw[mf] = f32x4{0.f, 0.f, 0.f, 0.f}; acca[mf] = accw[mf]; accg[mf] = accw[mf]; accr[mf] = accw[mf]; acci[mf] = accw[mf];
  }
  {
    const bf16_t* W2T = (const bf16_t*)(p.ws + WS_W2T);
    const bf16_t* A2T = (const bf16_t*)(p.ws + WS_A2T);
    const bf16_t* G2T = (const bf16_t*)(p.ws + WS_G2T);
    const bf16_t* WAT = (const bf16_t*)(p.ws + WS_WAT);
    const bf16_t* WXT = (const bf16_t*)(p.ws + WS_WXT);
    bf16x8 al[8], ax[2];
#pragma unroll
    for (int ks = 0; ks < 8; ++ks) al[ks] = *reinterpret_cast<const bf16x8*>(latA + fr * LSTR + ks * 32 + fq * 8);
#pragma unroll
    for (int ks = 0; ks < 2; ++ks) ax[ks] = *reinterpret_cast<const bf16x8*>(xcA + fr * LSTR + wid * 64 + ks * 32 + fq * 8);
#pragma unroll
    for (int mf = 0; mf < 4; ++mf) {
      const int n = wid * 64 + mf * 16 + fr;
#pragma unroll
      for (int ks = 0; ks < 2; ++ks) {
        const bf16x8 bw = *reinterpret_cast<const bf16x8*>(W2T + n * 64 + ks * 32 + fq * 8);
        const bf16x8 ba = *reinterpret_cast<const bf16x8*>(A2T + n * 64 + ks * 32 + fq * 8);
        const bf16x8 br = *reinterpret_cast<const bf16x8*>(WAT + n * 64 + ks * 32 + fq * 8);
        const bf16x8 bi = *reinterpret_cast<const bf16x8*>(WXT + n * 64 + ks * 32 + fq * 8);
        accw[mf] = __builtin_amdgcn_mfma_f32_16x16x32_bf16(bw, al[ks], accw[mf], 0, 0, 0);
        acca[mf] = __builtin_amdgcn_mfma_f32_16x16x32_bf16(ba, al[2 + ks], acca[mf], 0, 0, 0);
        accr[mf] = __builtin_amdgcn_mfma_f32_16x16x32_bf16(br, ax[ks], accr[mf], 0, 0, 0);
        acci[mf] = __builtin_amdgcn_mfma_f32_16x16x32_bf16(bi, ax[ks], acci[mf], 0, 0, 0);
      }
#pragma unroll
      for (int ks = 0; ks < 4; ++ks) {
        const bf16x8 bg = *reinterpret_cast<const bf16x8*>(G2T + n * 128 + ks * 32 + fq * 8);
        accg[mf] = __builtin_amdgcn_mfma_f32_16x16x32_bf16(bg, al[4 + ks], accg[mf], 0, 0, 0);
      }
    }
  }
  {
    const int tt = fr;
    const size_t row = (size_t)(r0 + tt);
    float kkv[16], kpv[16], avv[16], rv[16];
    float ss = 0.f, cf = 0.f;
#pragma unroll
    for (int mf = 0; mf < 4; ++mf) {
      const int c = wid * 64 + mf * 16 + fq * 4;
      const float4 r4 = *reinterpret_cast<const float4*>(pm + tt * PMS + c);
      const float4 k4 = *reinterpret_cast<const float4*>(pm + tt * PMS + 256 + c);
      const float4 a0 = *reinterpret_cast<const float4*>(p.in[17] + l * 256 + c);
      const float4 kkc = *reinterpret_cast<const float4*>(p.in[20] + l * 256 + c);
      const float4 kac = *reinterpret_cast<const float4*>(p.in[21] + l * 256 + c);
      const float4 rkc = *reinterpret_cast<const float4*>(p.in[22] + l * 256 + c);
      const float rr_[4] = {r4.x, r4.y, r4.z, r4.w}, kk_[4] = {k4.x, k4.y, k4.z, k4.w};
      const float a0_[4] = {a0.x, a0.y, a0.z, a0.w}, kkc_[4] = {kkc.x, kkc.y, kkc.z, kkc.w};
      const float kac_[4] = {kac.x, kac.y, kac.z, kac.w}, rkc_[4] = {rkc.x, rkc.y, rkc.z, rkc.w};
#pragma unroll
      for (int j = 0; j < 4; ++j) {
        const int x = mf * 4 + j;
        rv[x] = rr_[j];
        avv[x] = sigmoidf_(a0_[j] + acca[mf][j]);
        kkv[x] = kk_[j] * kkc_[j];
        ss += kkv[x] * kkv[x];
        kpv[x] = kk_[j] * (1.f + (avv[x] - 1.f) * kac_[j]);
        cf += rv[x] * kpv[x] * rkc_[j];
      }
    }
    ss += __shfl_xor(ss, 16, 64); ss += __shfl_xor(ss, 32, 64);
    cf += __shfl_xor(cf, 16, 64); cf += __shfl_xor(cf, 32, 64);
    const float inv = 1.f / fmaxf(sqrtf(ss), 1e-12f);
    float4 w0a[4], baa[4], bxa[4], lama[4];
#pragma unroll
    for (int mf = 0; mf < 4; ++mf) {
      const int c = wid * 64 + mf * 16 + fq * 4;
      w0a[mf] = *reinterpret_cast<const float4*>(p.in[15] + l * 256 + c);
      baa[mf] = *reinterpret_cast<const float4*>(p.in[28] + l * 256 + c);
      bxa[mf] = *reinterpret_cast<const float4*>(p.in[30] + l * 256 + c);
      lama[mf] = *reinterpret_cast<const float4*>(p.in[31] + l * 256 + c);
    }
    if (fq == 0) RC[row * 4 + wid] = cf;
#pragma unroll
    for (int mf = 0; mf < 4; ++mf) {
      const int c = wid * 64 + mf * 16 + fq * 4;
      const float4 w0 = w0a[mf], ba = baa[mf], bx = bxa[mf], lam = lama[mf];
      const float w0_[4] = {w0.x, w0.y, w0.z, w0.w}, ba_[4] = {ba.x, ba.y, ba.z, ba.w};
      const float bx_[4] = {bx.x, bx.y, bx.z, bx.w}, lam_[4] = {lam.x, lam.y, lam.z, lam.w};
      const uint2 xcr = *reinterpret_cast<const uint2*>(xcA + tt * LSTR + c);
      const float xc_[4] = {lo2f(xcr.x), hi2f(xcr.x), lo2f(xcr.y), hi2f(xcr.y)};
      float omw[4], kn[4], bb[4], la[4], uu[4];
#pragma unroll
      for (int j = 0; j < 4; ++j) {
        const int x = mf * 4 + j;
        const float wv = w0_[j] + accw[mf][j];
        const float w = -softplus_fast(-wv) - 0.5f;
        omw[j] = 1.f - __expf(-__expf(w));
        kn[j] = kkv[x] * inv;
        bb[j] = kn[j] * avv[x];
        const float rr = sigmoidf_(accr[mf][j] + ba_[j]), ii = sigmoidf_(acci[mf][j] + bx_[j]);
        la[j] = -8.f * rr * softplus_fast(-lam_[j]);
        uu[j] = sqrtf(fmaxf(1.f - __expf(2.f * la[j]), 0.f)) * (ii * xc_[j]);
      }
      bf16_t* o = RW + row * 1536 + c;
      *reinterpret_cast<uint2*>(o) = make_uint2(pack2(omw[0], omw[1]), pack2(omw[2], omw[3]));
      *reinterpret_cast<uint2*>(o + 256) = make_uint2(pack2(kn[0], kn[1]), pack2(kn[2], kn[3]));
      *reinterpret_cast<uint2*>(o + 512) = make_uint2(pack2(bb[0], bb[1]), pack2(bb[2], bb[3]));
      *reinterpret_cast<uint2*>(o + 768) = make_uint2(pack2(kpv[mf * 4], kpv[mf * 4 + 1]), pack2(kpv[mf * 4 + 2], kpv[mf * 4 + 3]));
      *reinterpret_cast<uint2*>(o + 1024) = make_uint2(pack2(rv[mf * 4], rv[mf * 4 + 1]), pack2(rv[mf * 4 + 2], rv[mf * 4 + 3]));
      *reinterpret_cast<uint2*>(RG + row * 256 + c) = make_uint2(pack2(accg[mf][0], accg[mf][1]), pack2(accg[mf][2], accg[mf][3]));
      *reinterpret_cast<uint2*>(LR + row * 512 + c) = make_uint2(pack2(la[0], la[1]), pack2(la[2], la[3]));
      *reinterpret_cast<uint2*>(LR + row * 512 + 256 + c) = make_uint2(pack2(uu[0], uu[1]), pack2(uu[2], uu[3]));
    }
  }
}

__device__ __forceinline__ void rwkv_scan_unit(CP p, int u, char* smem) {
  float* buf = (float*)smem;
  const int tid = tidx(), wid = tid >> 6, lane = tid & 63, i = lane >> 4, j = lane & 15;
  const int b = u >> 4, h = (u >> 2) & 3, q = u & 3;
  const int rowv = q * 16 + wid * 4 + i;
  const bf16_t* RW = (const bf16_t*)(p.ws + WS_RW);
  bf16_t* Y = (bf16_t*)(p.ws + WS_Y);
  float s0 = 0.f, s1 = 0.f, s2 = 0.f, s3 = 0.f;
  uint4 st[3];
  auto gload = [&](int c) {
    const int rb = rowof(b, c * 16);
#pragma unroll
    for (int x = 0; x < 3; ++x) {
      const int e = tid + x * 256, tok = e / 48, rem = e % 48, vec = rem >> 3, part = rem & 7;
      st[x] = *reinterpret_cast<const uint4*>(RW + (size_t)(rb + tok) * 1536 + vec * 256 + h * 64 + part * 8);
    }
  };
  auto lwrite = [&](int bi) {
#pragma unroll
    for (int x = 0; x < 3; ++x) {
      const int e = tid + x * 256, tok = e / 48, rem = e % 48, vec = rem >> 3, part = rem & 7;
      float* d = buf + bi * 6144 + tok * 384 + vec * 64 + part * 8;
      *reinterpret_cast<float4*>(d) = make_float4(lo2f(st[x].x), hi2f(st[x].x), lo2f(st[x].y), hi2f(st[x].y));
      *reinterpret_cast<float4*>(d + 4) = make_float4(lo2f(st[x].z), hi2f(st[x].z), lo2f(st[x].w), hi2f(st[x].w));
    }
  };
  half_barrier(smem);
  gload(0);
  lwrite(0);
  half_barrier(smem);
  constexpr int NCH = T / 16;
  for (int c = 0; c < NCH; ++c) {
    if (c + 1 < NCH) gload(c + 1);
    const float* cb = buf + (c & 1) * 6144;
    float ykeep = 0.f;
    float4 om = *reinterpret_cast<const float4*>(cb + j * 4);
    float4 kk = *reinterpret_cast<const float4*>(cb + 64 + j * 4);
    float4 bb = *reinterpret_cast<const float4*>(cb + 128 + j * 4);
    float4 kp = *reinterpret_cast<const float4*>(cb + 192 + j * 4);
    float4 rr = *reinterpret_cast<const float4*>(cb + 256 + j * 4);
    float vv = cb[320 + rowv];
#pragma unroll 2
    for (int s = 0; s < 16; ++s) {
      const float* sb = cb + (s + 1) * 384;
      const float4 om_n = *reinterpret_cast<const float4*>(sb + j * 4);
      const float4 kk_n = *reinterpret_cast<const float4*>(sb + 64 + j * 4);
      const float4 bb_n = *reinterpret_cast<const float4*>(sb + 128 + j * 4);
      const float4 kp_n = *reinterpret_cast<const float4*>(sb + 192 + j * 4);
      const float4 rr_n = *reinterpret_cast<const float4*>(sb + 256 + j * 4);
      const float vv_n = sb[320 + rowv];
      __builtin_amdgcn_sched_barrier(0);
      float d = s0 * kk.x + s1 * kk.y + s2 * kk.z + s3 * kk.w;
      d = allreduce16(d);
      const float sa = -d;
      s0 = fmaf(-s0, om.x, s0); s1 = fmaf(-s1, om.y, s1); s2 = fmaf(-s2, om.z, s2); s3 = fmaf(-s3, om.w, s3);
      s0 = fmaf(sa, bb.x, s0); s1 = fmaf(sa, bb.y, s1); s2 = fmaf(sa, bb.z, s2); s3 = fmaf(sa, bb.w, s3);
      s0 = fmaf(vv, kp.x, s0); s1 = fmaf(vv, kp.y, s1); s2 = fmaf(vv, kp.z, s2); s3 = fmaf(vv, kp.w, s3);
      float y = s0 * rr.x + s1 * rr.y + s2 * rr.z + s3 * rr.w;
      y = allreduce16(y);
      if (j == s) ykeep = y;
      om = om_n; kk = kk_n; bb = bb_n; kp = kp_n; rr = rr_n; vv = vv_n;
    }
    Y[(size_t)(rowof(b, c * 16) + j) * 1024 + 256 + h * 64 + rowv] = f2bf(ykeep);
    if (c + 1 < NCH) lwrite((c + 1) & 1);
    half_barrier(smem);
  }
}

__device__ __forceinline__ void ssd_scan_unit(CP p, int l, int u, char* smem) {
  constexpr int SST = 296;
  float* buf = (float*)smem;
  const int tid = tidx(), wid = tid >> 6, lane = tid & 63, i = lane >> 4, j = lane & 15;
  const int b = u >> 4, h = (u >> 2) & 3, q = u & 3, g = h >> 1;
  const int prow = wid * 4 + i;
  const bf16_t* SS = (const bf16_t*)(p.ws + WS_SS);
  const float* SD = (const float*)(p.ws + WS_SD);
  bf16_t* Y = (bf16_t*)(p.ws + WS_Y);
  const float Ah = -__expf(p.in[11][l * 4 + h]);
  const float Dh = p.in[12][l * 4 + h];
  float hs[8];
#pragma unroll
  for (int n = 0; n < 8; ++n) hs[n] = 0.f;
  uint4 st[2];
  unsigned short stxr = 0;
  float stdt = 0.f;
  auto gload = [&](int c) {
    const int rb = rowof(b, c * 16);
#pragma unroll
    for (int x = 0; x < 2; ++x) {
      const int e = tid + x * 256, tok = e >> 5, rem = e & 31, which = rem >> 4, part = rem & 15;
      st[x] = *reinterpret_cast<const uint4*>(SS + (size_t)(rb + tok) * 768 + 256 + which * 256 + g * 128 + part * 8);
    }
    {
      const int tok = tid >> 4, pp = tid & 15;
      stxr = SS[(size_t)(rb + tok) * 768 + h * 64 + q * 16 + pp];
      stdt = SD[(size_t)(rb + tok) * 4 + h];
    }
  };
  auto lwrite = [&](int bi) {
#pragma unroll
    for (int x = 0; x < 2; ++x) {
      const int e = tid + x * 256, tok = e >> 5, rem = e & 31, which = rem >> 4, part = rem & 15;
      float* d = buf + bi * 16 * SST + tok * SST + which * 128 + part * 8;
      *reinterpret_cast<float4*>(d) = make_float4(lo2f(st[x].x), hi2f(st[x].x), lo2f(st[x].y), hi2f(st[x].y));
      *reinterpret_cast<float4*>(d + 4) = make_float4(lo2f(st[x].z), hi2f(st[x].z), lo2f(st[x].w), hi2f(st[x].w));
    }
    {
      const int tok = tid >> 4, pp = tid & 15;
      float* d = buf + bi * 16 * SST + tok * SST;
      const float stx = bf2f(stxr);
      d[256 + pp] = stx * stdt;
      d[272 + pp] = stx;
      if (pp == 0) d[288] = __expf(stdt * Ah);
    }
  };
  half_barrier(smem);
  gload(0);
  lwrite(0);
  half_barrier(smem);
  constexpr int NCH = T / 16;
  for (int c = 0; c < NCH; ++c) {
    if (c + 1 < NCH) gload(c + 1);
    const float* cb = buf + (c & 1) * 16 * SST;
    float ykeep = 0.f;
    float4 B0 = *reinterpret_cast<const float4*>(cb + j * 4), B1 = *reinterpret_cast<const float4*>(cb + 64 + j * 4);
    float4 C0 = *reinterpret_cast<const float4*>(cb + 128 + j * 4), C1 = *reinterpret_cast<const float4*>(cb + 192 + j * 4);
    float xdt = cb[256 + prow], xr = cb[272 + prow], a = cb[288];
#pragma unroll 2
    for (int s = 0; s < 16; ++s) {
      const float* sb = cb + (s + 1) * SST;
      const float4 B0n = *reinterpret_cast<const float4*>(sb + j * 4), B1n = *reinterpret_cast<const float4*>(sb + 64 + j * 4);
      const float4 C0n = *reinterpret_cast<const float4*>(sb + 128 + j * 4), C1n = *reinterpret_cast<const float4*>(sb + 192 + j * 4);
      const float xdtn = sb[256 + prow], xrn = sb[272 + prow], an = sb[288];
      __builtin_amdgcn_sched_barrier(0);
      hs[0] = fmaf(a, hs[0], xdt * B0.x); hs[1] = fmaf(a, hs[1], xdt * B0.y); hs[2] = fmaf(a, hs[2], xdt * B0.z); hs[3] = fmaf(a, hs[3], xdt * B0.w);
      hs[4] = fmaf(a, hs[4], xdt * B1.x); hs[5] = fmaf(a, hs[5], xdt * B1.y); hs[6] = fmaf(a, hs[6], xdt * B1.z); hs[7] = fmaf(a, hs[7], xdt * B1.w);
      float y = hs[0] * C0.x + hs[1] * C0.y + hs[2] * C0.z + hs[3] * C0.w + hs[4] * C1.x + hs[5] * C1.y + hs[6] * C1.z + hs[7] * C1.w;
      y = allreduce16(y);
      y = fmaf(Dh, xr, y);
      if (j == s) ykeep = y;
      B0 = B0n; B1 = B1n; C0 = C0n; C1 = C1n; xdt = xdtn; xr = xrn; a = an;
    }
    Y[(size_t)(rowof(b, c * 16) + j) * 1024 + h * 64 + q * 16 + prow] = f2bf(ykeep);
    if (c + 1 < NCH) lwrite((c + 1) & 1);
    half_barrier(smem);
  }
}

__device__ __forceinline__ void ret_scan_unit(CP p, int l, int u, char* smem) {
  float* buf = (float*)smem;
  float* ybuf0 = buf + 2 * 16 * 128;
  const int tid = tidx(), e = tid >> 2, dsl = tid & 3;
  const int b = u >> 2, h = u & 3;
  const bf16_t* proj = (const bf16_t*)(p.ws + WS_PROJ);
  const float* rope = (const float*)(p.ws + WS_ROPE);
  bf16_t* Y = (bf16_t*)(p.ws + WS_Y);
  const float gdec = 1.f - exp2f(-5.f - (float)h);
  float S[8];
#pragma unroll
  for (int n = 0; n < 8; ++n) S[n] = 0.f;
  const int stok = tid >> 4, spart = tid & 15;
  uint4 sa_, sb_;
  float4 rp0, rp1, rp2, rp3;
  uint2 gg_n, gg_c;
  const int s_qk = (spart >> 2) & 1, s_pp = spart & 3;
  const int offa = (spart < 8) ? (OFF_RET + s_qk * 128 + h * 32 + s_pp * 8) : (OFF_RET + 256 + h * 64 + (spart - 8) * 8);
  const int offb = (spart < 8) ? (OFF_RET + s_qk * 128 + h * 32 + (s_pp ^ 2) * 8) : offa;
  const int ech = h * 64 + spart * 4;
  const float4 gw = *reinterpret_cast<const float4*>(p.in[32] + l * 256 + ech);
  auto gload = [&](int c) {
    const size_t row = (size_t)(rowof(b, c * 16) + stok);
    sa_ = *reinterpret_cast<const uint4*>(proj + row * PJ + offa);
    sb_ = *reinterpret_cast<const uint4*>(proj + row * PJ + offb);
    const float* rpp = rope + ((size_t)(c * 16 + stok) * 16 + (s_pp & 1) * 8) * 2;
    rp0 = *reinterpret_cast<const float4*>(rpp);
    rp1 = *reinterpret_cast<const float4*>(rpp + 4);
    rp2 = *reinterpret_cast<const float4*>(rpp + 8);
    rp3 = *reinterpret_cast<const float4*>(rpp + 12);
    gg_n = *reinterpret_cast<const uint2*>(proj + row * PJ + OFF_RET + 512 + ech);
  };
  auto lwrite = [&](int bi) {
    float* d = buf + bi * 2048 + stok * 128;
    float a[8];
    a[0] = lo2f(sa_.x); a[1] = hi2f(sa_.x); a[2] = lo2f(sa_.y); a[3] = hi2f(sa_.y);
    a[4] = lo2f(sa_.z); a[5] = hi2f(sa_.z); a[6] = lo2f(sa_.w); a[7] = hi2f(sa_.w);
    if (spart < 8) {
      float o[8];
      o[0] = lo2f(sb_.x); o[1] = hi2f(sb_.x); o[2] = lo2f(sb_.y); o[3] = hi2f(sb_.y);
      o[4] = lo2f(sb_.z); o[5] = hi2f(sb_.z); o[6] = lo2f(sb_.w); o[7] = hi2f(sb_.w);
      const float cs[16] = {rp0.x, rp0.y, rp0.z, rp0.w, rp1.x, rp1.y, rp1.z, rp1.w, rp2.x, rp2.y, rp2.z, rp2.w, rp3.x, rp3.y, rp3.z, rp3.w};
      const float sc = s_qk ? 0.17677669529663687f : 1.f;
      float r[8];
#pragma unroll
      for (int n = 0; n < 8; ++n) {
        r[n] = (s_pp < 2) ? (a[n] * cs[2 * n] - o[n] * cs[2 * n + 1]) : (o[n] * cs[2 * n + 1] + a[n] * cs[2 * n]);
        r[n] *= sc;
      }
      float* dd = d + s_qk * 32 + s_pp * 8;
      *reinterpret_cast<float4*>(dd) = make_float4(r[0], r[1], r[2], r[3]);
      *reinterpret_cast<float4*>(dd + 4) = make_float4(r[4], r[5], r[6], r[7]);
    } else {
      float* dd = d + 64 + (spart - 8) * 8;
      *reinterpret_cast<float4*>(dd) = make_float4(a[0], a[1], a[2], a[3]);
      *reinterpret_cast<float4*>(dd + 4) = make_float4(a[4], a[5], a[6], a[7]);
    }
  };
  half_barrier(smem);
  gload(0);
  lwrite(0);
  gg_c = gg_n;
  half_barrier(smem);
  constexpr int NCH = T / 16;
  for (int c = 0; c < NCH; ++c) {
    if (c + 1 < NCH) gload(c + 1);
    const float* cb = buf + (c & 1) * 2048;
    float* ybuf = ybuf0 + (c & 1) * 1024;
    float4 q0 = *reinterpret_cast<const float4*>(cb + dsl * 8), q1 = *reinterpret_cast<const float4*>(cb + dsl * 8 + 4);
    float4 k0 = *reinterpret_cast<const float4*>(cb + 32 + dsl * 8), k1 = *reinterpret_cast<const float4*>(cb + 32 + dsl * 8 + 4);
    float v = cb[64 + e];
#pragma unroll 2
    for (int s = 0; s < 16; ++s) {
      const float* sb = cb + (s + 1) * 128;
      const float4 q0n = *reinterpret_cast<const float4*>(sb + dsl * 8), q1n = *reinterpret_cast<const float4*>(sb + dsl * 8 + 4);
      const float4 k0n = *reinterpret_cast<const float4*>(sb + 32 + dsl * 8), k1n = *reinterpret_cast<const float4*>(sb + 32 + dsl * 8 + 4);
      const float vn = sb[64 + e];
      __builtin_amdgcn_sched_barrier(0);
      S[0] = fmaf(gdec, S[0], k0.x * v); S[1] = fmaf(gdec, S[1], k0.y * v); S[2] = fmaf(gdec, S[2], k0.z * v); S[3] = fmaf(gdec, S[3], k0.w * v);
      S[4] = fmaf(gdec, S[4], k1.x * v); S[5] = fmaf(gdec, S[5], k1.y * v); S[6] = fmaf(gdec, S[6], k1.z * v); S[7] = fmaf(gdec, S[7], k1.w * v);
      float y = S[0] * q0.x + S[1] * q0.y + S[2] * q0.z + S[3] * q0.w + S[4] * q1.x + S[5] * q1.y + S[6] * q1.z + S[7] * q1.w;
      y = allreduce4(y);
      ybuf[s * 64 + e] = y;
      q0 = q0n; q1 = q1n; k0 = k0n; k1 = k1n; v = vn;
    }
    if (c + 1 < NCH) lwrite((c + 1) & 1);
    half_barrier(smem);
    {
      const float4 yv = *reinterpret_cast<const float4*>(ybuf + stok * 64 + spart * 4);
      const float mu = allreduce16(yv.x + yv.y + yv.z + yv.w) * (1.f / 64.f);
      const float d0 = yv.x - mu, d1 = yv.y - mu, d2 = yv.z - mu, d3 = yv.w - mu;
      const float var = allreduce16(d0 * d0 + d1 * d1 + d2 * d2 + d3 * d3) * (1.f / 64.f);
      const float rs = rsqrtf(var + 1e-5f);
      const size_t row = (size_t)(rowof(b, c * 16) + stok);
      uint2 o;
      o.x = pack2(d0 * rs * gw.x * siluf_(lo2f(gg_c.x)), d1 * rs * gw.y * siluf_(hi2f(gg_c.x)));
      o.y = pack2(d2 * rs * gw.z * siluf_(lo2f(gg_c.y)), d3 * rs * gw.w * siluf_(hi2f(gg_c.y)));
      *reinterpret_cast<uint2*>(Y + row * 1024 + 768 + ech) = o;
    }
    gg_c = gg_n;
  }
}


__device__ __forceinline__ void ret_mfma_unit(CP p, int l, int u, char* smem) {
  const int tid = tidx(), wv = tid >> 6, lane = tid & 63, r = lane & 15, fq = lane >> 4;
  const int bh = u * 2 + (wv >> 1), b = bh >> 2, h = bh & 3, eh = wv & 1;
  char* wl = smem + wv * 8192;
  bf16_t* KT = (bf16_t*)wl;
  bf16_t* VT = (bf16_t*)(wl + 1024);
  bf16_t* PT = (bf16_t*)(wl + 3072);
  bf16_t* ST = (bf16_t*)(wl + 4096);
  const bf16_t* proj = (const bf16_t*)(p.ws + WS_PROJ);
  const float* rope = (const float*)(p.ws + WS_ROPE);
  bf16_t* Y = (bf16_t*)(p.ws + WS_Y);
  half_barrier(smem);
  for (int i = lane; i < 512; i += 64) reinterpret_cast<unsigned*>(ST)[i] = 0u;
  const float lg = log2f(1.f - exp2f(-5.f - (float)h));
  const float dk = exp2f(lg * (float)(15 - r)), dq = exp2f(lg * (float)(r + 1)), d16 = exp2f(lg * 16.f);
  float pw[4];
#pragma unroll
  for (int jj = 0; jj < 4; ++jj) { const int t = fq * 4 + jj; pw[jj] = (r <= t) ? exp2f(lg * (float)(t - r)) : 0.f; }
  f32x4 Sacc[2][2];
#pragma unroll
  for (int mf = 0; mf < 2; ++mf)
#pragma unroll
    for (int nf = 0; nf < 2; ++nf) Sacc[mf][nf] = f32x4{0.f, 0.f, 0.f, 0.f};
  const bf16x8 zero8 = {0, 0, 0, 0, 0, 0, 0, 0};
  const bool lowk = fq < 2;
  uint4 qa, qb, ka, kb, v0, nqa, nqb, nka, nkb, nv0, mqa, mqb, mka, mkb, mv0;
  float4 rp0, rp1, rp2, rp3, nrp0, nrp1, nrp2, nrp3;
  constexpr int NCH = T / 16;
#define RET_GLOAD(c, QA, QB, KA, KB, V0) do { \
    const bf16_t* pr_ = proj + (size_t)(rowof(b, (c) * 16) + r) * PJ + OFF_RET; \
    QA = *reinterpret_cast<const uint4*>(pr_ + h * 32 + fq * 8); \
    QB = *reinterpret_cast<const uint4*>(pr_ + h * 32 + (fq ^ 2) * 8); \
    KA = *reinterpret_cast<const uint4*>(pr_ + 128 + h * 32 + fq * 8); \
    KB = *reinterpret_cast<const uint4*>(pr_ + 128 + h * 32 + (fq ^ 2) * 8); \
    V0 = *reinterpret_cast<const uint4*>(pr_ + 256 + h * 64 + eh * 32 + fq * 8); \
  } while (0)
#define RET_ROPE(c, R0, R1, R2, R3) do { \
    const float* rq_ = rope + ((size_t)((c) * 16 + r) * 16 + (fq & 1) * 8) * 2; \
    R0 = *reinterpret_cast<const float4*>(rq_); R1 = *reinterpret_cast<const float4*>(rq_ + 4); \
    R2 = *reinterpret_cast<const float4*>(rq_ + 8); R3 = *reinterpret_cast<const float4*>(rq_ + 12); \
  } while (0)
  RET_GLOAD(0, qa, qb, ka, kb, v0);
  RET_ROPE(0, rp0, rp1, rp2, rp3);
  RET_GLOAD(1, nqa, nqb, nka, nkb, nv0);
  for (int c = 0; c < NCH; ++c) {
    RET_GLOAD((c + 2 < NCH) ? c + 2 : c, mqa, mqb, mka, mkb, mv0);
    RET_ROPE((c + 1 < NCH) ? c + 1 : c, nrp0, nrp1, nrp2, nrp3);
    const float cs[16] = {rp0.x, rp0.y, rp0.z, rp0.w, rp1.x, rp1.y, rp1.z, rp1.w, rp2.x, rp2.y, rp2.z, rp2.w, rp3.x, rp3.y, rp3.z, rp3.w};
    const unsigned qaw[4] = {qa.x, qa.y, qa.z, qa.w}, qbw[4] = {qb.x, qb.y, qb.z, qb.w};
    const unsigned kaw[4] = {ka.x, ka.y, ka.z, ka.w}, kbw[4] = {kb.x, kb.y, kb.z, kb.w};
    float qf[8], kf[8];
#pragma unroll
    for (int n = 0; n < 8; ++n) {
      const float qo = (n & 1) ? hi2f(qaw[n >> 1]) : lo2f(qaw[n >> 1]);
      const float qp = (n & 1) ? hi2f(qbw[n >> 1]) : lo2f(qbw[n >> 1]);
      const float ko = (n & 1) ? hi2f(kaw[n >> 1]) : lo2f(kaw[n >> 1]);
      const float kp = (n & 1) ? hi2f(kbw[n >> 1]) : lo2f(kbw[n >> 1]);
      const float cc = cs[2 * n], sn = cs[2 * n + 1];
      qf[n] = lowk ? (qo * cc - qp * sn) : (qp * sn + qo * cc);
      kf[n] = (lowk ? (ko * cc - kp * sn) : (kp * sn + ko * cc)) * 0.17677669529663687f;
    }
    bf16x8 Qf, Kf, Qs;
#pragma unroll
    for (int n = 0; n < 8; ++n) { Qf[n] = (short)f2bf(qf[n]); Kf[n] = (short)f2bf(kf[n]); Qs[n] = (short)f2bf(qf[n] * dq); }
    f32x4 P = __builtin_amdgcn_mfma_f32_16x16x32_bf16(Qf, Kf, f32x4{0.f, 0.f, 0.f, 0.f}, 0, 0, 0);
#pragma unroll
    for (int jj = 0; jj < 4; ++jj) PT[(fq * 4 + jj) * 16 + r] = f2bf(P[jj] * pw[jj]);
#pragma unroll
    for (int n = 0; n < 8; ++n) KT[(fq * 8 + n) * 16 + r] = f2bf(kf[n] * dk);
    {
      const unsigned vw[4] = {v0.x, v0.y, v0.z, v0.w};
#pragma unroll
      for (int i = 0; i < 8; ++i) VT[(fq * 8 + i) * 16 + r] = (bf16_t)((i & 1) ? (vw[i >> 1] >> 16) : (vw[i >> 1] & 0xffffu));
    }
    asm volatile("s_waitcnt lgkmcnt(0)" ::: "memory");
    bf16x8 Pf = *reinterpret_cast<const bf16x8*>(PT + r * 16 + (fq & 1) * 8);
    Pf = lowk ? Pf : zero8;
    bf16x8 VTf[2], STf[2], KTf[2];
#pragma unroll
    for (int nf = 0; nf < 2; ++nf) {
      VTf[nf] = *reinterpret_cast<const bf16x8*>(VT + (nf * 16 + r) * 16 + (fq & 1) * 8);
      VTf[nf] = lowk ? VTf[nf] : zero8;
      STf[nf] = *reinterpret_cast<const bf16x8*>(ST + (nf * 16 + r) * 32 + fq * 8);
    }
#pragma unroll
    for (int mf = 0; mf < 2; ++mf) {
      KTf[mf] = *reinterpret_cast<const bf16x8*>(KT + (mf * 16 + r) * 16 + (fq & 1) * 8);
      KTf[mf] = lowk ? KTf[mf] : zero8;
    }
    asm volatile("s_waitcnt lgkmcnt(0)" ::: "memory");
    f32x4 Yv[2];
#pragma unroll
    for (int nf = 0; nf < 2; ++nf) {
      Yv[nf] = __builtin_amdgcn_mfma_f32_16x16x32_bf16(Qs, STf[nf], f32x4{0.f, 0.f, 0.f, 0.f}, 0, 0, 0);
      Yv[nf] = __builtin_amdgcn_mfma_f32_16x16x32_bf16(Pf, VTf[nf], Yv[nf], 0, 0, 0);
    }
#pragma unroll
    for (int mf = 0; mf < 2; ++mf)
#pragma unroll
      for (int nf = 0; nf < 2; ++nf) {
        Sacc[mf][nf] = Sacc[mf][nf] * d16;
        Sacc[mf][nf] = __builtin_amdgcn_mfma_f32_16x16x32_bf16(KTf[mf], VTf[nf], Sacc[mf][nf], 0, 0, 0);
        *reinterpret_cast<uint2*>(ST + (nf * 16 + r) * 32 + mf * 16 + fq * 4) =
            make_uint2(pack2(Sacc[mf][nf][0], Sacc[mf][nf][1]), pack2(Sacc[mf][nf][2], Sacc[mf][nf][3]));
      }
    const int rb = rowof(b, c * 16);
#pragma unroll
    for (int jj = 0; jj < 4; ++jj)
#pragma unroll
      for (int nf = 0; nf < 2; ++nf)
        Y[(size_t)(rb + fq * 4 + jj) * 1024 + 768 + h * 64 + eh * 32 + nf * 16 + r] = f2bf(Yv[nf][jj]);
    asm volatile("s_waitcnt lgkmcnt(0)" ::: "memory");
    qa = nqa; qb = nqb; ka = nka; kb = nkb; v0 = nv0;
    nqa = mqa; nqb = mqb; nka = mka; nkb = mkb; nv0 = mv0;
    rp0 = nrp0; rp1 = nrp1; rp2 = nrp2; rp3 = nrp3;
  }
#undef RET_ROPE
#undef RET_GLOAD
}

__device__ __forceinline__ float gelu_tanh(float x) {
  const float u = 0.7978845608028654f * (x + 0.044715f * x * x * x);
  return 0.5f * x * (1.f + tanhf(u));
}
__device__ __forceinline__ void lru_scan_unit(CP p, int u, char* smem) {
  float* segS = (float*)smem;
  float* segH = segS + 256;
  const int tid = tidx(), seg = tid >> 6, lane = tid & 63;
  const int b = u >> 2, ch = (u & 3) * 64 + lane;
  const bf16_t* LR = (const bf16_t*)(p.ws + WS_LR);
  const bf16_t* proj = (const bf16_t*)(p.ws + WS_PROJ);
  bf16_t* Y = (bf16_t*)(p.ws + WS_Y);
  constexpr int SEGL = T / 4;
  const int tb = seg * SEGL;
  half_barrier(smem);
  constexpr int LB = 12, NBAT = SEGL / LB;
  float hl = 0.f, S = 0.f;
  {
    unsigned short la[LB], uu[LB], lan[LB], uun[LB];
#pragma unroll
    for (int x = 0; x < LB; ++x) {
      const size_t row = (size_t)rowof(b, tb + x);
      la[x] = LR[row * 512 + ch]; uu[x] = LR[row * 512 + 256 + ch];
    }
    for (int k = 0; k < NBAT; ++k) {
      const int tn = tb + (k + 1 < NBAT ? k + 1 : k) * LB;
#pragma unroll
      for (int x = 0; x < LB; ++x) {
        const size_t row = (size_t)rowof(b, tn + x);
        lan[x] = LR[row * 512 + ch]; uun[x] = LR[row * 512 + 256 + ch];
      }
#pragma unroll
      for (int x = 0; x < LB; ++x) {
        const float l_ = bf2f(la[x]);
        hl = fmaf(__expf(l_), hl, bf2f(uu[x]));
        S += l_;
      }
#pragma unroll
      for (int x = 0; x < LB; ++x) { la[x] = lan[x]; uu[x] = uun[x]; }
    }
  }
  segS[seg * 64 + lane] = S;
  segH[seg * 64 + lane] = hl;
  half_barrier(smem);
  float hh = 0.f;
  for (int q = 0; q < seg; ++q) hh = fmaf(__expf(segS[q * 64 + lane]), hh, segH[q * 64 + lane]);
  {
    unsigned short la[LB], uu[LB], gb[LB], lan[LB], uun[LB], gbn[LB];
#pragma unroll
    for (int x = 0; x < LB; ++x) {
      const size_t row = (size_t)rowof(b, tb + x);
      la[x] = LR[row * 512 + ch]; uu[x] = LR[row * 512 + 256 + ch]; gb[x] = proj[row * PJ + OFF_LRU + 256 + ch];
    }
    for (int k = 0; k < NBAT; ++k) {
      const int tn = tb + (k + 1 < NBAT ? k + 1 : k) * LB;
#pragma unroll
      for (int x = 0; x < LB; ++x) {
        const size_t row = (size_t)rowof(b, tn + x);
        lan[x] = LR[row * 512 + ch]; uun[x] = LR[row * 512 + 256 + ch]; gbn[x] = proj[row * PJ + OFF_LRU + 256 + ch];
      }
#pragma unroll
      for (int x = 0; x < LB; ++x) {
        hh = fmaf(__expf(bf2f(la[x])), hh, bf2f(uu[x]));
        Y[(size_t)rowof(b, tb + k * LB + x) * 1024 + 512 + ch] = f2bf(hh * gelu_tanh(bf2f(gb[x])));
      }
#pragma unroll
      for (int x = 0; x < LB; ++x) { la[x] = lan[x]; uu[x] = uun[x]; gb[x] = gbn[x]; }
    }
  }
}

__device__ __forceinline__ void epi_phase(CP p, int l) {
  const int tid_ = tidx(); const int lane = tid_ & 63, gw = bidx() * 4 + (tid_ >> 6), nw = nvb() * 4;
  const bf16_t* proj = (const bf16_t*)(p.ws + WS_PROJ);
  const bf16_t* RW = (const bf16_t*)(p.ws + WS_RW);
  const bf16_t* RG = (const bf16_t*)(p.ws + WS_RG);
  const float* RC = (const float*)(p.ws + WS_RC);
  bf16_t* Y = (bf16_t*)(p.ws + WS_Y);
  const int c = lane * 4;
  const float4 nw4 = *reinterpret_cast<const float4*>(p.in[13] + l * 256 + c);
  const float4 lw4 = *reinterpret_cast<const float4*>(p.in[23] + l * 256 + c);
  const float4 lb4 = *reinterpret_cast<const float4*>(p.in[24] + l * 256 + c);
  for (int row = gw; row < R; row += nw) {
    {
      const uint2 yr = *reinterpret_cast<const uint2*>(Y + (size_t)row * 1024 + c);
      const uint2 zr = *reinterpret_cast<const uint2*>(proj + (size_t)row * PJ + OFF_Z + c);
      const float y0 = lo2f(yr.x) * siluf_(lo2f(zr.x)), y1 = hi2f(yr.x) * siluf_(hi2f(zr.x));
      const float y2 = lo2f(yr.y) * siluf_(lo2f(zr.y)), y3 = hi2f(yr.y) * siluf_(hi2f(zr.y));
      float ss = y0 * y0 + y1 * y1 + y2 * y2 + y3 * y3;
#pragma unroll
      for (int o = 16; o >= 1; o >>= 1) ss += __shfl_xor(ss, o, 64);
      const float rs = rsqrtf(ss * (1.f / 128.f) + EPS);
      uint2 o;
      o.x = pack2(y0 * rs * nw4.x, y1 * rs * nw4.y);
      o.y = pack2(y2 * rs * nw4.z, y3 * rs * nw4.w);
      *reinterpret_cast<uint2*>(Y + (size_t)row * 1024 + c) = o;
    }
    {
      const uint2 yr = *reinterpret_cast<const uint2*>(Y + (size_t)row * 1024 + 768 + c);
      const uint2 gr = *reinterpret_cast<const uint2*>(proj + (size_t)row * PJ + OFF_RET + 512 + c);
      const float4 gw = *reinterpret_cast<const float4*>(p.in[32] + l * 256 + c);
      const float y0 = lo2f(yr.x), y1 = hi2f(yr.x), y2 = lo2f(yr.y), y3 = hi2f(yr.y);
      float sm = y0 + y1 + y2 + y3;
#pragma unroll
      for (int o = 8; o >= 1; o >>= 1) sm += __shfl_xor(sm, o, 64);
      const float mu = sm * (1.f / 64.f);
      const float d0 = y0 - mu, d1 = y1 - mu, d2 = y2 - mu, d3 = y3 - mu;
      float vs = d0 * d0 + d1 * d1 + d2 * d2 + d3 * d3;
#pragma unroll
      for (int o = 8; o >= 1; o >>= 1) vs += __shfl_xor(vs, o, 64);
      const float rs = rsqrtf(vs * (1.f / 64.f) + 1e-5f);
      uint2 o;
      o.x = pack2(d0 * rs * gw.x * siluf_(lo2f(gr.x)), d1 * rs * gw.y * siluf_(hi2f(gr.x)));
      o.y = pack2(d2 * rs * gw.z * siluf_(lo2f(gr.y)), d3 * rs * gw.w * siluf_(hi2f(gr.y)));
      *reinterpret_cast<uint2*>(Y + (size_t)row * 1024 + 768 + c) = o;
    }
    {
      const uint2 yr = *reinterpret_cast<const uint2*>(Y + (size_t)row * 1024 + 256 + c);
      const float y0 = lo2f(yr.x), y1 = hi2f(yr.x), y2 = lo2f(yr.y), y3 = hi2f(yr.y);
      float sm = y0 + y1 + y2 + y3;
#pragma unroll
      for (int o = 8; o >= 1; o >>= 1) sm += __shfl_xor(sm, o, 64);
      const float mu = sm * (1.f / 64.f);
      const float d0 = y0 - mu, d1 = y1 - mu, d2 = y2 - mu, d3 = y3 - mu;
      float vs = d0 * d0 + d1 * d1 + d2 * d2 + d3 * d3;
#pragma unroll
      for (int o = 8; o >= 1; o >>= 1) vs += __shfl_xor(vs, o, 64);
      const float rs = rsqrtf(vs * (1.f / 64.f) + 64e-5f);
      const float coef = RC[(size_t)row * 4 + (lane >> 4)];
      const uint2 vr = *reinterpret_cast<const uint2*>(RW + (size_t)row * 1536 + 1280 + c);
      const uint2 gr = *reinterpret_cast<const uint2*>(RG + (size_t)row * 256 + c);
      const float o0 = (d0 * rs * lw4.x + lb4.x + coef * lo2f(vr.x)) * lo2f(gr.x);
      const float o1 = (d1 * rs * lw4.y + lb4.y + coef * hi2f(vr.x)) * hi2f(gr.x);
      const float o2 = (d2 * rs * lw4.z + lb4.z + coef * lo2f(vr.y)) * lo2f(gr.y);
      const float o3 = (d3 * rs * lw4.w + lb4.w + coef * hi2f(vr.y)) * hi2f(gr.y);
      uint2 o;
      o.x = pack2(o0, o1);
      o.y = pack2(o2, o3);
      *reinterpret_cast<uint2*>(Y + (size_t)row * 1024 + 256 + c) = o;
    }
  }
}


#define XB_TMO      128
#define XB_XCNT(j)  (256  + 64 * (j))
#define XB_XSUB(j)  (1280 + 64 * (j))
#define XB_XGEN(j)  (2304 + 64 * (j))
#define XB_TOP      3328
#define XB_TOPGEN   3392
#define XCD_BAR_WORDS 3456
#define XB_SPIN_CAP (1u << 20)
#define LAS __attribute__((address_space(3)))
__device__ __forceinline__ unsigned xb_ld(unsigned* p) { return __hip_atomic_load(p, __ATOMIC_RELAXED, __HIP_MEMORY_SCOPE_AGENT); }
__device__ __forceinline__ unsigned xb_add(unsigned* p, unsigned v) { return __hip_atomic_fetch_add(p, v, __ATOMIC_RELAXED, __HIP_MEMORY_SCOPE_AGENT); }
__device__ __forceinline__ unsigned xb_xcc_id() { return (unsigned)__builtin_amdgcn_s_getreg((3 << 11) | 20) & 0xFu; }
#define XB_SPIN(cond, bar) do { unsigned _sp = 0; while (cond) { __builtin_amdgcn_s_sleep(1); \
    if ((++_sp & 255u) == 0u) { if (xb_ld(&(bar)[XB_TMO])) break; if (_sp > XB_SPIN_CAP) { atomicAdd(&(bar)[XB_TMO], 1u); break; } } } } while (0)
struct XcdBarrier { unsigned* bar; unsigned x; volatile LAS unsigned* st; };
__device__ __forceinline__ XcdBarrier xcd_barrier_post(unsigned* bar, volatile LAS unsigned* st) {
  XcdBarrier b; b.bar = bar; b.x = xb_xcc_id(); b.st = st;
  if (threadIdx.x == 0) (void)xb_add(&bar[XB_XCNT(b.x)], 1u);
  return b;
}
__device__ __forceinline__ void xcd_barrier_complete(unsigned* bar, unsigned x, unsigned& nloc, unsigned& nx) {
  const unsigned G = gridDim.x * gridDim.y * gridDim.z;
  unsigned sum, cnt, mine, sp = 0u;
  for (;;) {
    sum = 0u; cnt = 0u; mine = 0u;
#pragma unroll
    for (unsigned j = 0; j < 16; ++j) { const unsigned c = xb_ld(&bar[XB_XCNT(j)]); sum += c; cnt += (c > 0u) ? 1u : 0u; mine = (j == x) ? c : mine; }
    if (sum == G) break;
    __builtin_amdgcn_s_sleep(1);
    if ((++sp & 255u) == 0u) { if (xb_ld(&bar[XB_TMO])) break; if (sp > XB_SPIN_CAP) { atomicAdd(&bar[XB_TMO], 1u); break; } }
  }
  nloc = mine > 0u ? mine : 1u; nx = cnt > 0u ? cnt : 1u;
}
__device__ __forceinline__ void xcd_barrier(const XcdBarrier& b) {
  asm volatile("s_waitcnt vmcnt(0)" ::: "memory");
  __syncthreads();
  if (threadIdx.x == 0) {
    unsigned* bar = b.bar;
    __builtin_amdgcn_s_waitcnt(0);
    unsigned nloc = b.st[0], nx = b.st[1];
    if (nloc == 0u) { xcd_barrier_complete(bar, b.x, nloc, nx); b.st[0] = nloc; b.st[1] = nx; }
    const unsigned old = xb_add(&bar[XB_XSUB(b.x)], 1u);
    const unsigned gen = old / nloc;
    if (old + 1u == (gen + 1u) * nloc) {
      __builtin_amdgcn_fence(__ATOMIC_RELEASE, "agent");
      asm volatile("s_waitcnt vmcnt(0)" ::: "memory");
      const unsigned og = xb_add(&bar[XB_TOP], 1u);
      const unsigned tg = og / nx;
      if (og + 1u == (tg + 1u) * nx) xb_add(&bar[XB_TOPGEN], 1u);
      else XB_SPIN(xb_ld(&bar[XB_TOPGEN]) == tg, bar);
      __builtin_amdgcn_fence(__ATOMIC_ACQUIRE, "agent");
      xb_add(&bar[XB_XGEN(b.x)], 1u);
      asm volatile("s_waitcnt vmcnt(0)" ::: "memory");
    } else {
      XB_SPIN(xb_ld(&bar[XB_XGEN(b.x)]) == gen, bar);
      __builtin_amdgcn_fence(__ATOMIC_ACQUIRE, "agent");
      asm volatile("s_waitcnt vmcnt(0)" ::: "memory");
    }
  }
  __syncthreads();
}

constexpr int NPH = NL * 9 + 1;
#ifndef SCAN_REP
#define SCAN_REP 0
#endif
#ifndef PH_MASK
#define PH_MASK 0x3ff
#endif

__device__ __forceinline__ void run_phase(CP p, int ph, char* smem_full) {
  const int l = ph / 9, s = ph % 9;
  const int vb = bidx(), NVB = nvb();
  char* smem = smem_full + half_id() * 65536;
  bf16_t* WA = (bf16_t*)(p.ws + WS_WA);
  bf16_t* WB = (bf16_t*)(p.ws + WS_WB);
  bf16_t* WO = (bf16_t*)(p.ws + WS_WO);
  bf16_t* PROJ = (bf16_t*)(p.ws + WS_PROJ);
  bf16_t* Yb = (bf16_t*)(p.ws + WS_Y);
  float* TMP = (float*)(p.ws + WS_TMP);
  if (ph == NPH - 1) {
    rowwise_phase(p, 1, p.in[5] + (NL - 1) * D, nullptr, false, DFF / 256);
    return;
  }
  if (!((PH_MASK >> s) & 1)) return;
  switch (s) {
    case 0: {
      if (l == 0) {
        float2* rope = (float2*)(p.ws + WS_ROPE);
        for (int i = vb * 256 + tidx(); i < T * 16; i += NVB * 256) {
          const int t = i >> 4, f = i & 15;
          const float freq = powf(10000.f, -(float)f / 16.f);
          const float ang = (float)t * freq;
          rope[i] = make_float2(cosf(ang), sinf(ang));
        }
        rowwise_phase(p, 0, nullptr, p.in[2], true, 0);
      } else {
        rowwise_phase(p, 1, p.in[5] + (l - 1) * D, p.in[2] + l * D, true, DFF / 256);
      }
      conv_matrix(p.in[6] + (size_t)l * D * MIXIN, WA, D, MIXIN, NIN_PAD, 0, smem, vb, NVB);
      for (int id = NVB - 1 - vb; id < 24; id += NVB) {
        if (id < 4) conv_tile(p.in[16] + (size_t)l * 64 * 256, (bf16_t*)(p.ws + WS_W2T), 64, 256, 0, id * 64, 0, smem);
        else if (id < 8) conv_tile(p.in[18] + (size_t)l * 64 * 256, (bf16_t*)(p.ws + WS_A2T), 64, 256, 0, (id - 4) * 64, 0, smem);
        else if (id < 16) conv_tile(p.in[19] + (size_t)l * 128 * 256, (bf16_t*)(p.ws + WS_G2T), 128, 256, ((id - 8) & 1) * 64, ((id - 8) >> 1) * 64, 0, smem);
        else if (id < 20) conv_tile(p.in[27] + (size_t)l * 16384 + (size_t)(id - 16) * 4096, (bf16_t*)(p.ws + WS_WAT) + (id - 16) * 4096, 64, 64, 0, 0, 0, smem);
        else conv_tile(p.in[29] + (size_t)l * 16384 + (size_t)(id - 20) * 4096, (bf16_t*)(p.ws + WS_WXT) + (id - 20) * 4096, 64, 64, 0, 0, 0, smem);
      }
    } break;
    case 1: gemm_phase256<EPI_BF16>(Yb, WA, D, 14, smem_full, PROJ, PJ, MIXIN); break;
    case 2: {
      for (int u = vb; u < NB * 129; u += NVB) prep_unit(p, l, u, smem);
    } break;
    case 3: {
      for (int u = vb; u < 320; u += NVB) {
        if (u < 128) { for (int rr_ = 0; rr_ < ((SCAN_REP >> 0) & 1) + 1; ++rr_) rwkv_scan_unit(p, u, smem); }
        else if (u < 256) { for (int rr_ = 0; rr_ < ((SCAN_REP >> 1) & 1) + 1; ++rr_) ssd_scan_unit(p, l, u - 128, smem); }
        else if (u < 272) ret_mfma_unit(p, l, u - 256, smem);
        else if (u < 288) { }
        else if (u < 320) { for (int rr_ = 0; rr_ < ((SCAN_REP >> 3) & 1) + 1; ++rr_) lru_scan_unit(p, u - 288, smem); }
      }
      {
        const int nwork = NVB > 320 ? NVB - 320 : NVB;
        const int wk = NVB > 320 ? vb - 320 : vb;
        const int ngu = 16 * 44;
        if (wk >= 0) {
          for (int id = wk; id < 256 + 2 * ngu + 44 * 16; id += nwork) {
            if (id < 256) conv_tile(p.in[7] + (size_t)l * D * D, WO, D, D, (id % 16) * 64, (id / 16) * 64, 0, smem);
            else if (id < 256 + ngu) { const int k = id - 256; conv_tile(p.in[33] + (size_t)l * D * DFF, WA, D, DFF, (k % 16) * 64, (k / 16) * 64, 1, smem); }
            else if (id < 256 + 2 * ngu) { const int k = id - 256 - ngu; conv_tile(p.in[34] + (size_t)l * D * DFF, WA, D, DFF, (k % 16) * 64, (k / 16) * 64, 2, smem); }
            else { const int k = id - 256 - 2 * ngu; conv_tile(p.in[35] + (size_t)l * DFF * D, WB, DFF, D, (k % 44) * 64, (k / 44) * 64, 0, smem); }
          }
        }
      }
    } break;
    case 4: epi_phase(p, l); break;
    case 5: gemm_phase_n1024<D>(p, Yb, WO, smem_full, TMP); break;
    case 8: gemm_phase_n1024<DFF>(p, PROJ, WB, smem_full, TMP); break;
    case 6: rowwise_phase(p, 1, p.in[3] + l * D, p.in[4] + l * D, true, D / 256); break;
    case 7: gemm_phase256<EPI_GLU>(Yb, WA, D, 22, smem_full, PROJ, DFF, DFF); break;
  }
}

#ifndef SCAN_REP
#define SCAN_REP 0
#endif
#ifndef REPEAT_MASK
#define REPEAT_MASK 0
#endif
__global__ void __launch_bounds__(512) hybrid_trunk_kernel(Params p, int ph_lo, int ph_hi) {
  __shared__ __attribute__((aligned(16))) char smem[131072 + 16];
  cg::grid_group grid = cg::this_grid();
#if MULTI_LAUNCH
  for (int ph = ph_lo; ph < ph_hi; ++ph) {
    run_phase(*(const __attribute__((address_space(4))) Params*)__builtin_amdgcn_kernarg_segment_ptr(), ph, smem);
    if (ph + 1 < ph_hi) grid.sync();
  }
#else
  volatile LAS unsigned* stw = (volatile LAS unsigned*)(smem + 131072);
  if (threadIdx.x < 4) stw[threadIdx.x] = 0u;
  __syncthreads();
  XcdBarrier xb = xcd_barrier_post((unsigned*)(p.ws + WS_BAR), stw);
  if (ph_hi < 0) grid.sync();
  for (int ph = ph_lo; ph < ph_hi; ++ph) {
    const int nrep = (REPEAT_MASK != 0 && ph < NPH - 1 && ((REPEAT_MASK >> (ph % 9)) & 1)) ? 2 : 1;
    for (int r = 0; r < nrep; ++r) {
      {
        const __attribute__((address_space(4))) Params* pp = (const __attribute__((address_space(4))) Params*)__builtin_amdgcn_kernarg_segment_ptr();
        asm volatile("" : "+s"(pp));
        run_phase(*pp, ph, smem);
      }
      if (r + 1 < nrep || ph + 1 < ph_hi) xcd_barrier(xb);
    }
  }
#endif
}

extern "C" void kernel_launch(void* const* d_in, const int* in_sizes, int n_in, void* d_out, int out_size, void* d_ws,
                              size_t ws_size, hipStream_t stream) {
  static int grid_blocks = 0;
  if (!grid_blocks) {
    int dev = 0, cus = 0, per_cu = 0;
    hipGetDevice(&dev);
    hipDeviceGetAttribute(&cus, hipDeviceAttributeMultiprocessorCount, dev);
    hipOccupancyMaxActiveBlocksPerMultiprocessor(&per_cu, hybrid_trunk_kernel, 512, 0);
    if (per_cu > 1) per_cu = 1;
    if (per_cu < 1) per_cu = 1;
    grid_blocks = cus * per_cu;
  }
  if (ws_size < WS_TOTAL || n_in < 36) {
    fprintf(stderr, "workspace too small: %zu < %zu\n", ws_size, (size_t)WS_END);
    return;
  }
  Params p{};
  for (int i = 0; i < 36; ++i) p.in[i] = (const float*)d_in[i];
  p.out = (float*)d_out;
  p.ws = (char*)d_ws;
#if MULTI_LAUNCH
  for (int ph = 0; ph < NPH; ++ph) {
    hipLaunchKernelGGL(hybrid_trunk_kernel, dim3(grid_blocks), dim3(512), 0, stream, p, ph, ph + 1);
  }
#else
  hipMemsetAsync((char*)d_ws + WS_BAR, 0, XCD_BAR_WORDS * 4, stream);
  int lo = 0, hi = NPH;
  void* args[] = {&p, &lo, &hi};
  hipError_t e = hipLaunchCooperativeKernel((void*)hybrid_trunk_kernel, dim3(grid_blocks), dim3(512), args, 0, stream);
  if (e != hipSuccess) fprintf(stderr, "cooperative launch failed: %s (grid %d)\n", hipGetErrorString(e), grid_blocks);
#endif
}
```

```cpp
#include <hip/hip_runtime.h>
#include <hip/hip_bf16.h>
#include <hip/hip_cooperative_groups.h>
#include <cstdio>
#include <cstdint>
namespace cg = cooperative_groups;

#ifndef MULTI_LAUNCH
#define MULTI_LAUNCH 0
#endif

typedef unsigned short bf16_t;
using bf16x8 = __attribute__((ext_vector_type(8))) short;
using f32x4 = __attribute__((ext_vector_type(4))) float;

constexpr int D = 1024, NB = 8, SEQ = 2048, NMETA = 16, T = 2064, R = NB * T, NL = 4;
constexpr int RREAL = NB * SEQ;
constexpr int MIXIN = 3332, PJ = 3336, NIN_PAD = 3456, DFF = 2816;
constexpr int OFF_Z = 0, OFF_XBC = 256, OFF_DT = 1024, OFF_RW = 1028, OFF_LRU = 2052, OFF_RET = 2564;
constexpr float EPS = 1e-6f;

constexpr size_t WS_BAR = 0;
constexpr size_t WS_HMETA = 16384;
constexpr size_t WS_ROPE = WS_HMETA + 128 * 1024 * 4;
constexpr size_t WS_WA = 1048576;
constexpr size_t WS_WB = WS_WA + (size_t)5632 * 1024 * 2;
constexpr size_t WS_PROJ = WS_WB + (size_t)1024 * 2816 * 2;
constexpr size_t WS_Y = WS_PROJ + (size_t)R * PJ * 2;
constexpr size_t WS_SCR = WS_Y + (size_t)R * 1024 * 2;
constexpr size_t WS_RW = WS_SCR;
constexpr size_t WS_SS = WS_RW + (size_t)R * 1536 * 2;
constexpr size_t WS_LR = WS_SS + (size_t)R * 768 * 2;
constexpr size_t WS_RG = WS_LR + (size_t)R * 512 * 2;
constexpr size_t WS_RC = WS_RG + (size_t)R * 256 * 2;
constexpr size_t WS_SD = WS_RC + (size_t)R * 4 * 4;
constexpr size_t WS_END = WS_SD + (size_t)R * 4 * 4;
constexpr size_t WS_WO = WS_END;
constexpr size_t WS_TOTAL = WS_WO + (size_t)1024 * 1024 * 2;
constexpr size_t WS_TMP = WS_SCR;
static_assert((size_t)R * 1024 * 4 <= WS_END - WS_SCR, "tmp must fit in scratch");

struct Params {
  const float* in[36];
  float* out;
  char* ws;
};
typedef const __attribute__((address_space(4))) Params& CP;

__device__ __forceinline__ float bf2f(bf16_t v) { return __uint_as_float(((unsigned)v) << 16); }
typedef __bf16 hwbf16x2 __attribute__((ext_vector_type(2)));
typedef float hwf32x2 __attribute__((ext_vector_type(2)));
__device__ __forceinline__ unsigned pack2(float a, float b) {
  const hwf32x2 v = {a, b};
  const hwbf16x2 r = __builtin_convertvector(v, hwbf16x2);
  return __builtin_bit_cast(unsigned, r);
}
__device__ __forceinline__ bf16_t f2bf(float f) { return (bf16_t)(pack2(f, 0.f) & 0xffffu); }
__device__ __forceinline__ float lo2f(unsigned w) { return __uint_as_float(w << 16); }
__device__ __forceinline__ float hi2f(unsigned w) { return __uint_as_float(w & 0xffff0000u); }
__device__ __forceinline__ float sigmoidf_(float x) { return __builtin_amdgcn_rcpf(1.f + __expf(-x)); }
__device__ __forceinline__ float softplusf_(float x) { return fmaxf(x, 0.f) + log1pf(__expf(-fabsf(x))); }
__device__ __forceinline__ float siluf_(float x) { return x * __builtin_amdgcn_rcpf(1.f + __expf(-x)); }
__device__ __forceinline__ float wave_sum(float v) {
#pragma unroll
  for (int o = 32; o >= 1; o >>= 1) v += __shfl_xor(v, o, 64);
  return v;
}
__device__ __forceinline__ int tidx() { int t = threadIdx.x & 255; asm volatile("" : "+v"(t)); return t; }
__device__ __forceinline__ int tidx_full() { int t = threadIdx.x; asm volatile("" : "+v"(t)); return t; }
__device__ __forceinline__ int half_id() { int t = (int)(threadIdx.x >> 8); asm volatile("" : "+v"(t)); return __builtin_amdgcn_readfirstlane(t); }
__device__ __forceinline__ int bidx() { int t = blockIdx.x + half_id() * gridDim.x; asm volatile("" : "+s"(t)); return t; }
__device__ __forceinline__ int nvb() { return gridDim.x * 2; }
#define LAS3 __attribute__((address_space(3)))
__device__ __forceinline__ void half_barrier(char* smem_half) {
  const int h = half_id();
  LAS3 unsigned* cnt = (LAS3 unsigned*)(smem_half + (2 - h) * 65536 + 8 + h * 4);
  asm volatile("s_waitcnt lgkmcnt(0)" ::: "memory");
  if ((tidx() & 63) == 0) {
    const unsigned old = __hip_atomic_fetch_add(cnt, 1u, __ATOMIC_RELAXED, __HIP_MEMORY_SCOPE_WORKGROUP);
    const unsigned target = (old & ~3u) + 4u;
    while (__hip_atomic_load(cnt, __ATOMIC_RELAXED, __HIP_MEMORY_SCOPE_WORKGROUP) < target) __builtin_amdgcn_s_sleep(1);
  }
  asm volatile("" ::: "memory");
}
template <int CTRL>
__device__ __forceinline__ float dppf(float x) {
  return __int_as_float(__builtin_amdgcn_update_dpp(0, __float_as_int(x), CTRL, 0xF, 0xF, true));
}
__device__ __forceinline__ float allreduce4(float x) {
  x += dppf<0xB1>(x);
  x += dppf<0x4E>(x);
  return x;
}
__device__ __forceinline__ float allreduce16(float x) {
  x += dppf<0xB1>(x);
  x += dppf<0x4E>(x);
  x += dppf<0x141>(x);
  x += dppf<0x140>(x);
  return x;
}
__device__ __forceinline__ int rowof(int b, int t) { return t < NMETA ? RREAL + b * NMETA + t : b * SEQ + t - NMETA; }
__device__ __forceinline__ float* hrow_ptr(CP p, int row) {
  return row < RREAL ? p.out + (size_t)row * D : (float*)(p.ws + WS_HMETA) + (size_t)(row - RREAL) * D;
}

__device__ __forceinline__ int lds_byte(int r, int c) {
  int st = (r >> 4) * 2 + (c >> 5), rr = r & 15, cc = c & 31, ob = rr * 64 + cc * 2;
  return st * 1024 + (ob ^ (((ob >> 9) & 1) << 5));
}
__device__ __forceinline__ void stage_rc(int b, int& Rr, int& Cc) {
  int st = b / 1024, sb = b % 1024, swz = sb ^ (((sb >> 9) & 1) << 5);
  Rr = (st >> 1) * 16 + swz / 64;
  Cc = (st & 1) * 32 + (swz % 64) / 2;
}
typedef __attribute__((address_space(3))) unsigned lds_u32;
typedef __attribute__((address_space(1))) const unsigned glb_u32;

enum { EPI_BF16 = 0, EPI_F32 = 1, EPI_GLU = 2, EPI_PART = 3 };

template <int EPI>
__device__ __forceinline__ void gemm_tile256(const bf16_t* __restrict__ A, const bf16_t* __restrict__ Bt, int K, int nk, int brow, int bcol,
                             char* smem, void* outp, int ldo, int nvalid) {
  const int tid = tidx_full(), wid = tid >> 6, lane = tid & 63, wr = wid >> 2, wc = wid & 3, fr = lane & 15, fq = lane >> 4;
  f32x4 acc[8][4];
#pragma unroll
  for (int m = 0; m < 8; ++m)
#pragma unroll
    for (int n = 0; n < 4; ++n) acc[m][n] = f32x4{0.f, 0.f, 0.f, 0.f};
  const bf16_t* Ab = A + (size_t)brow * K;
  const bf16_t* Bb = Bt + (size_t)bcol * K;
  int soff[4];
#pragma unroll
  for (int i = 0; i < 4; ++i) {
    int r, c;
    stage_rc(tid * 16 + i * 8192, r, c);
    soff[i] = r * K + c;
  }
  auto stage = [&](int buf, int kt) {
    char* sa = smem + buf * 65536;
    char* sb = sa + 32768;
#pragma unroll
    for (int i = 0; i < 4; ++i) {
      const int b = tid * 16 + i * 8192;
      __builtin_amdgcn_global_load_lds((glb_u32*)(Ab + soff[i] + kt * 64), (lds_u32*)(sa + b), 16, 0, 0);
      __builtin_amdgcn_global_load_lds((glb_u32*)(Bb + soff[i] + kt * 64), (lds_u32*)(sb + b), 16, 0, 0);
    }
  };
  stage(0, 0);
  for (int kt = 0; kt < nk; ++kt) {
    asm volatile("s_waitcnt vmcnt(0)" ::: "memory");
    __syncthreads();
    if (kt + 1 < nk) stage((kt + 1) & 1, kt + 1);
    const char* sa = smem + (kt & 1) * 65536;
    const char* sb = sa + 32768;
#pragma unroll
    for (int k = 0; k < 2; ++k) {
      bf16x8 af[8], bfr[4];
#pragma unroll
      for (int m = 0; m < 8; ++m) af[m] = *reinterpret_cast<const bf16x8*>(sa + lds_byte(wr * 128 + m * 16 + fr, k * 32 + fq * 8));
#pragma unroll
      for (int n = 0; n < 4; ++n) bfr[n] = *reinterpret_cast<const bf16x8*>(sb + lds_byte(wc * 64 + n * 16 + fr, k * 32 + fq * 8));
      __builtin_amdgcn_sched_barrier(0);
#pragma unroll
      for (int m = 0; m < 8; ++m)
#pragma unroll
        for (int n = 0; n < 4; ++n) acc[m][n] = __builtin_amdgcn_mfma_f32_16x16x32_bf16(bfr[n], af[m], acc[m][n], 0, 0, 0);
      __builtin_amdgcn_sched_barrier(0);
    }
  }
  __syncthreads();
  if (EPI == EPI_BF16) {
    bf16_t* O = (bf16_t*)outp;
#pragma unroll
    for (int m = 0; m < 8; ++m) {
      const int row = brow + wr * 128 + m * 16 + fr;
#pragma unroll
      for (int n = 0; n < 4; ++n) {
        const int col = bcol + wc * 64 + n * 16 + fq * 4;
        if (col < nvalid && row < R)
          *reinterpret_cast<uint2*>(O + (size_t)row * ldo + col) = make_uint2(pack2(acc[m][n][0], acc[m][n][1]), pack2(acc[m][n][2], acc[m][n][3]));
      }
    }
  } else if (EPI == EPI_F32) {
    float* O = (float*)outp;
#pragma unroll
    for (int m = 0; m < 8; ++m) {
      const int row = brow + wr * 128 + m * 16 + fr;
#pragma unroll
      for (int n = 0; n < 4; ++n) {
        const int col = bcol + wc * 64 + n * 16 + fq * 4;
        if (row < R) *reinterpret_cast<float4*>(O + (size_t)row * ldo + col) = make_float4(acc[m][n][0], acc[m][n][1], acc[m][n][2], acc[m][n][3]);
      }
    }
  } else if (EPI == EPI_PART) {
    float* O = (float*)outp;
    if (wr == 0) {
#pragma unroll
      for (int m = 0; m < 8; ++m)
#pragma unroll
        for (int n = 0; n < 4; ++n) {
          const int col = bcol + wc * 64 + n * 16 + fq * 4;
          *reinterpret_cast<float4*>(O + (size_t)(m * 16 + fr) * ldo + col) = make_float4(acc[m][n][0], acc[m][n][1], acc[m][n][2], acc[m][n][3]);
        }
    }
  } else {
    bf16_t* O = (bf16_t*)outp;
#pragma unroll
    for (int m = 0; m < 8; ++m) {
      const int row = brow + wr * 128 + m * 16 + fr;
#pragma unroll
      for (int n = 0; n < 2; ++n) {
        const int col = (bcol >> 8) * 128 + wc * 32 + n * 16 + fq * 4;
        float a[4];
#pragma unroll
        for (int j = 0; j < 4; ++j) a[j] = siluf_(acc[m][n][j]) * acc[m][n + 2][j];
        if (row < R) *reinterpret_cast<uint2*>(O + (size_t)row * ldo + col) = make_uint2(pack2(a[0], a[1]), pack2(a[2], a[3]));
      }
    }
  }
}

template <int EPI>
__device__ __forceinline__ void gemm_tile8p(const bf16_t* __restrict__ Ag, const bf16_t* __restrict__ Bg, int K, int nt, int brow, int bcol,
                                            char* smem, void* outp, int ldo, int nvalid, int rowoff, int rowlim) {
  constexpr int HT = 128 * 64, HALF = 128;
  bf16_t* shm = (bf16_t*)smem;
  const int tid = tidx_full();
  const int wid = tid >> 6, lane = tid & 63, wr = wid >> 2, wc = wid & 3, fr = lane & 15, fq = lane >> 4;
  int goff0;
  { int r, c; stage_rc(tid * 16, r, c); goff0 = r * K + c; }
#define SA8(b, h) (shm + ((b) * 2 + (h)) * HT)
#define SB8(b, h) (shm + (4 + (b) * 2 + (h)) * HT)
#define STAGE8(P, BASE, br, kt) do { const bf16_t* _g = (BASE) + (size_t)(br) * K + (kt) * 64; \
    _Pragma("unroll") for (int _i = 0; _i < 2; ++_i) \
      __builtin_amdgcn_global_load_lds((glb_u32*)(_g + goff0 + _i * 64 * K), (lds_u32*)((char*)(P) + tid * 16 + _i * 8192), 16, 0, 0); } while (0)
#define LDA8(dst, b, h) _Pragma("unroll") for (int m = 0; m < 4; ++m) _Pragma("unroll") for (int k = 0; k < 2; ++k) \
    dst[m][k] = *reinterpret_cast<const bf16x8*>((const char*)SA8(b, h) + lds_byte(wr * 64 + m * 16 + fr, k * 32 + fq * 8))
#define LDB8(dst, b, h) _Pragma("unroll") for (int n = 0; n < 2; ++n) _Pragma("unroll") for (int k = 0; k < 2; ++k) \
    dst[n][k] = *reinterpret_cast<const bf16x8*>((const char*)SB8(b, h) + lds_byte(wc * 32 + n * 16 + fr, k * 32 + fq * 8))
#define MMA8(ai, bj, Af, Bf) do { __builtin_amdgcn_s_setprio(3); \
    _Pragma("unroll") for (int m = 0; m < 4; ++m) _Pragma("unroll") for (int n = 0; n < 2; ++n) _Pragma("unroll") for (int k = 0; k < 2; ++k) \
      acc[ai][bj][m][n] = __builtin_amdgcn_mfma_f32_16x16x32_bf16(Af[m][k], Bf[n][k], acc[ai][bj][m][n], 0, 0, 0); \
    __builtin_amdgcn_s_setprio(0); } while (0)
#define WAIT_V8(n) asm volatile("s_waitcnt vmcnt(" #n ")" ::: "memory")
#define WAIT_L8(n) asm volatile("s_waitcnt lgkmcnt(" #n ")" ::: "memory")
#define BAR8 __builtin_amdgcn_s_barrier()
#define SCHED8 __builtin_amdgcn_sched_barrier(0)
  f32x4 acc[2][2][4][2];
#pragma unroll
  for (int a = 0; a < 2; ++a)
#pragma unroll
    for (int b = 0; b < 2; ++b)
#pragma unroll
      for (int m = 0; m < 4; ++m)
#pragma unroll
        for (int n = 0; n < 2; ++n) acc[a][b][m][n] = f32x4{0.f, 0.f, 0.f, 0.f};
  bf16x8 At[4][2], B0[2][2], B1[2][2];
  STAGE8(SB8(0, 0), Bg, bcol, 0); STAGE8(SA8(0, 0), Ag, brow, 0);
  STAGE8(SB8(0, 1), Bg, bcol + HALF, 0); STAGE8(SA8(0, 1), Ag, brow + HALF, 0);
  if (wr == 1) BAR8;
  WAIT_V8(4); BAR8;
  STAGE8(SB8(1, 0), Bg, bcol, 1); STAGE8(SA8(1, 0), Ag, brow, 1); STAGE8(SB8(1, 1), Bg, bcol + HALF, 1);
  WAIT_V8(6); BAR8;
  for (int t = 0; t < nt - 2; t += 2) {
    LDB8(B0, 0, 0); SCHED8; LDA8(At, 0, 0); STAGE8(SA8(1, 1), Ag, brow + HALF, t + 1);
    WAIT_L8(8); BAR8; WAIT_L8(0); MMA8(0, 0, At, B0); BAR8; SCHED8;
    LDB8(B1, 0, 1); STAGE8(SB8(0, 0), Bg, bcol, t + 2);
    BAR8; WAIT_L8(0); MMA8(0, 1, At, B1); BAR8;
    LDA8(At, 0, 1); STAGE8(SA8(0, 0), Ag, brow, t + 2);
    BAR8; WAIT_L8(0); MMA8(1, 0, At, B0); BAR8; SCHED8;
    STAGE8(SB8(0, 1), Bg, bcol + HALF, t + 2);
    WAIT_V8(6); BAR8; MMA8(1, 1, At, B1); BAR8;
    LDB8(B0, 1, 0); SCHED8; LDA8(At, 1, 0); STAGE8(SA8(0, 1), Ag, brow + HALF, t + 2);
    WAIT_L8(8); BAR8; WAIT_L8(0); MMA8(0, 0, At, B0); BAR8; SCHED8;
    LDB8(B1, 1, 1); STAGE8(SB8(1, 0), Bg, bcol, t + 3);
    BAR8; WAIT_L8(0); MMA8(0, 1, At, B1); BAR8;
    LDA8(At, 1, 1); STAGE8(SA8(1, 0), Ag, brow, t + 3);
    BAR8; WAIT_L8(0); MMA8(1, 0, At, B0); BAR8; SCHED8;
    STAGE8(SB8(1, 1), Bg, bcol + HALF, t + 3);
    WAIT_V8(6); BAR8; MMA8(1, 1, At, B1); BAR8;
  }
  { LDB8(B0, 0, 0); LDA8(At, 0, 0); STAGE8(SA8(1, 1), Ag, brow + HALF, nt - 1);
    BAR8; WAIT_L8(0); MMA8(0, 0, At, B0); BAR8;
    LDB8(B1, 0, 1); BAR8; WAIT_L8(0); MMA8(0, 1, At, B1); BAR8;
    LDA8(At, 0, 1); WAIT_V8(4); BAR8; WAIT_L8(0); MMA8(1, 0, At, B0); MMA8(1, 1, At, B1); BAR8; }
  { LDB8(B0, 1, 0); LDA8(At, 1, 0); WAIT_V8(2); BAR8; WAIT_L8(0); MMA8(0, 0, At, B0); BAR8;
    LDB8(B1, 1, 1); WAIT_V8(0); BAR8; WAIT_L8(0); MMA8(0, 1, At, B1); BAR8;
    LDA8(At, 1, 1); BAR8; WAIT_L8(0); MMA8(1, 0, At, B0); MMA8(1, 1, At, B1); BAR8; }
  if (wr == 0) BAR8;
#pragma unroll
  for (int ai = 0; ai < 2; ++ai)
#pragma unroll
    for (int m = 0; m < 4; ++m)
#pragma unroll
      for (int j = 0; j < 4; ++j) {
        const int rl = ai * HALF + wr * 64 + m * 16 + fq * 4 + j;
        const size_t orow = (size_t)(rowoff + rl) * ldo;
        if (EPI == EPI_GLU) {
#pragma unroll
          for (int n = 0; n < 2; ++n) {
            const int col = (bcol >> 8) * 128 + wc * 32 + n * 16 + fr;
            const float g = acc[ai][0][m][n][j], u = acc[ai][1][m][n][j];
            if (rl < rowlim) ((bf16_t*)outp)[orow + col] = f2bf(siluf_(g) * u);
          }
        } else {
#pragma unroll
          for (int bj = 0; bj < 2; ++bj)
#pragma unroll
            for (int n = 0; n < 2; ++n) {
              const int col = bcol + bj * HALF + wc * 32 + n * 16 + fr;
              const float v = acc[ai][bj][m][n][j];
              if (EPI == EPI_BF16) { if (rl < rowlim && col < nvalid) ((bf16_t*)outp)[orow + col] = f2bf(v); }
              else { if (rl < rowlim) ((float*)outp)[orow + col] = v; }
            }
        }
        __builtin_amdgcn_sched_barrier(0);
      }
#undef SA8
#undef SB8
#undef STAGE8
#undef LDA8
#undef LDB8
#undef MMA8
#undef WAIT_V8
#undef WAIT_L8
#undef BAR8
#undef SCHED8
  __syncthreads();
}

template <int EPI>
__device__ __forceinline__ void gemm_phase256(const bf16_t* A, const bf16_t* Bt, int K, int NT, char* smem, void* outp, int ldo, int nvalid) {
  constexpr int TM = (R + 255) / 256;
  const int ntiles = TM * NT;
  const int nb = gridDim.x;
  const int xcd = blockIdx.x & 7, slot = blockIdx.x >> 3, per = nb >> 3;
  for (int it = 0; it * nb < ntiles; ++it) {
    const int k = (it * 8 + xcd) * per + slot;
    if (k >= ntiles) continue;
    const int panel = k / (TM * 8);
    const int w = min(8, NT - panel * 8);
    const int idx = k - panel * TM * 8;
    const int tm = idx / w, tn = panel * 8 + idx % w;
    gemm_tile8p<EPI>(A, Bt, K, K >> 6, tm * 256, tn * 256, smem, outp, ldo, nvalid, tm * 256, R - tm * 256);
  }
}

constexpr size_t WS_PART = WS_TMP + (size_t)68 * 1024 * 1024;
static_assert(WS_PART + (size_t)11 * 128 * 1024 * 4 <= WS_END, "partial slabs must fit");
template <int K>
__device__ __forceinline__ void gemm_phase_n1024(CP p, const bf16_t* A, const bf16_t* Bt, char* smem, float* outp) {
  const int nb = gridDim.x;
  const int xcd = blockIdx.x & 7, slot = blockIdx.x >> 3, per = nb >> 3;
  const int nkc = K >> 8;
  const int nmain = 256, nitems = nmain + 4 * nkc;
  float* part = (float*)(p.ws + WS_PART);
  for (int it = 0; it * nb < nitems; ++it) {
    int id = it * nb + blockIdx.x;
    if ((it + 1) * nb <= nmain) id = (it * 8 + xcd) * per + slot;
    if (id >= nitems) break;
    const bf16_t* Ai = A; const bf16_t* Bi = Bt; float* Oi = outp;
    int nti = K >> 6, brow = (id >> 2) * 256, bcol = (id & 3) * 256, rowoff = brow, rowlim = 256;
    if (id >= nmain) {
      const int pid = id - nmain, kc = pid >> 2;
      Ai = A + kc * 256; Bi = Bt + kc * 256; Oi = part + (size_t)kc * 128 * 1024;
      nti = 4; brow = RREAL; bcol = (pid & 3) * 256; rowoff = 0; rowlim = 128;
    }
    gemm_tile8p<EPI_F32>(Ai, Bi, K, nti, brow, bcol, smem, Oi, D, D, rowoff, rowlim);
  }
}

__device__ __forceinline__ int map_n(int n, int maptype) {
  if (maptype == 0) return n;
  return (n >> 7) * 256 + (n & 127) + (maptype == 2 ? 128 : 0);
}
__device__ __forceinline__ void conv_tile(const float* __restrict__ src, bf16_t* __restrict__ dst, int K, int N, int k0, int n0, int maptype,
                          char* smem) {
  bf16_t* tile = (bf16_t*)smem;
  const int tid = tidx();
  half_barrier(smem);
#pragma unroll
  for (int i = 0; i < 4; ++i) {
    const int idx = tid + i * 256, k = idx >> 4, c4 = idx & 15, n = n0 + c4 * 4;
    float4 v = make_float4(0.f, 0.f, 0.f, 0.f);
    if (n < N) v = *reinterpret_cast<const float4*>(src + (size_t)(k0 + k) * N + n);
    tile[(c4 * 4 + 0) * 72 + k] = f2bf(v.x);
    tile[(c4 * 4 + 1) * 72 + k] = f2bf(v.y);
    tile[(c4 * 4 + 2) * 72 + k] = f2bf(v.z);
    tile[(c4 * 4 + 3) * 72 + k] = f2bf(v.w);
  }
  half_barrier(smem);
#pragma unroll
  for (int i = 0; i < 2; ++i) {
    const int idx = tid + i * 256, n = idx >> 3, kc = idx & 7;
    uint4 v = *reinterpret_cast<const uint4*>(tile + n * 72 + kc * 8);
    *reinterpret_cast<uint4*>(dst + (size_t)map_n(n0 + n, maptype) * K + k0 + kc * 8) = v;
  }
}
__device__ __forceinline__ void conv_matrix(const float* src, bf16_t* dst, int K, int N, int Npad, int maptype, char* smem, int start, int stride) {
  const int nkt = K / 64, nnt = Npad / 64;
  for (int id = start; id < nkt * nnt; id += stride) conv_tile(src, dst, K, N, (id % nkt) * 64, (id / nkt) * 64, maptype, smem);
}

__device__ __forceinline__ void rowwise_phase(CP p, int mode, const float* wpost, const float* wpre, bool write_hn, int nparts) {
  const int tid_ = tidx(); const int lane = tid_ & 63, gw = bidx() * 4 + (tid_ >> 6), nw = nvb() * 4;
  const float* tmp = (const float*)(p.ws + WS_TMP);
  bf16_t* hn = (bf16_t*)(p.ws + WS_Y);
  float4 wpo[4], wpr[4];
#pragma unroll
  for (int q = 0; q < 4; ++q) {
    wpo[q] = (mode != 0) ? *reinterpret_cast<const float4*>(wpost + q * 256 + lane * 4) : make_float4(0.f, 0.f, 0.f, 0.f);
    wpr[q] = write_hn ? *reinterpret_cast<const float4*>(wpre + q * 256 + lane * 4) : make_float4(0.f, 0.f, 0.f, 0.f);
  }
  float4 tv[4], hv[4], tvn[4], hvn[4], tvm[4], hvm[4];
  auto loadrow = [&](int row, float4 (&t)[4], float4 (&h)[4]) {
    if (mode == 0) {
      const float* src = row < RREAL ? p.in[0] + (size_t)row * D : p.in[1] + (size_t)((row - RREAL) & 15) * D;
#pragma unroll
      for (int q = 0; q < 4; ++q) { h[q] = *reinterpret_cast<const float4*>(src + q * 256 + lane * 4); t[q] = make_float4(0.f, 0.f, 0.f, 0.f); }
    } else {
      const float* hr = hrow_ptr(p, row);
#pragma unroll
      for (int q = 0; q < 4; ++q) {
        if (row < RREAL) {
          t[q] = *reinterpret_cast<const float4*>(tmp + (size_t)row * D + q * 256 + lane * 4);
        } else {
          const float* pp = (const float*)(p.ws + WS_PART) + (size_t)(row - RREAL) * D + q * 256 + lane * 4;
          float4 a = *reinterpret_cast<const float4*>(pp);
          for (int kc = 1; kc < nparts; ++kc) {
            const float4 c = *reinterpret_cast<const float4*>(pp + (size_t)kc * 128 * 1024);
            a.x += c.x; a.y += c.y; a.z += c.z; a.w += c.w;
          }
          t[q] = a;
        }
        h[q] = *reinterpret_cast<const float4*>(hr + q * 256 + lane * 4);
      }
    }
  };
  if (gw < R) loadrow(gw, tv, hv);
  if (gw + nw < R) loadrow(gw + nw, tvn, hvn);
  for (int row = gw; row < R; row += nw) {
    if (row + 2 * nw < R) loadrow(row + 2 * nw, tvm, hvm);
    float* hr = hrow_ptr(p, row);
    if (mode != 0) {
      float ss = 0.f;
#pragma unroll
      for (int q = 0; q < 4; ++q) ss += tv[q].x * tv[q].x + tv[q].y * tv[q].y + tv[q].z * tv[q].z + tv[q].w * tv[q].w;
      ss = wave_sum(ss);
      const float rs = rsqrtf(ss * (1.f / D) + EPS);
#pragma unroll
      for (int q = 0; q < 4; ++q) {
        hv[q].x += tv[q].x * rs * wpo[q].x;
        hv[q].y += tv[q].y * rs * wpo[q].y;
        hv[q].z += tv[q].z * rs * wpo[q].z;
        hv[q].w += tv[q].w * rs * wpo[q].w;
      }
    }
#pragma unroll
    for (int q = 0; q < 4; ++q) *reinterpret_cast<float4*>(hr + q * 256 + lane * 4) = hv[q];
    if (write_hn) {
      float ss = 0.f;
#pragma unroll
      for (int q = 0; q < 4; ++q) ss += hv[q].x * hv[q].x + hv[q].y * hv[q].y + hv[q].z * hv[q].z + hv[q].w * hv[q].w;
      ss = wave_sum(ss);
      const float rs = rsqrtf(ss * (1.f / D) + EPS);
#pragma unroll
      for (int q = 0; q < 4; ++q) {
        uint2 o;
        o.x = pack2(hv[q].x * rs * wpr[q].x, hv[q].y * rs * wpr[q].y);
        o.y = pack2(hv[q].z * rs * wpr[q].z, hv[q].w * rs * wpr[q].w);
        *reinterpret_cast<uint2*>(hn + (size_t)row * D + q * 256 + lane * 4) = o;
      }
    }
#pragma unroll
    for (int q = 0; q < 4; ++q) { tv[q] = tvn[q]; hv[q] = hvn[q]; tvn[q] = tvm[q]; hvn[q] = hvm[q]; }
  }
}

constexpr size_t WS_W2T = WS_WA - 196608;
constexpr size_t WS_A2T = WS_W2T + 32768;
constexpr size_t WS_G2T = WS_A2T + 32768;
constexpr size_t WS_WAT = WS_G2T + 65536;
constexpr size_t WS_WXT = WS_WAT + 32768;
static_assert(WS_W2T >= WS_ROPE + (size_t)T * 16 * 8, "small weights overlap rope");
constexpr int LSTR = 264;

constexpr int PMS = 516;
__device__ __forceinline__ float tanh_fast(float x) { return 1.f - 2.f * __builtin_amdgcn_rcpf(1.f + __expf(2.f * x)); }
__device__ __forceinline__ float softplus_fast(float x) { return fmaxf(x, 0.f) + __logf(1.f + __expf(-fabsf(x))); }
__device__ __forceinline__ uint2 ld_u2(const bf16_t* q) { return *reinterpret_cast<const uint2*>(q); }

__device__ __forceinline__ void prep_unit(CP p, int l, int u, char* smem) {
  float* pm = (float*)smem;
  bf16_t* latA = (bf16_t*)(smem + 16 * PMS * 4);
  bf16_t* xcA = latA + 16 * LSTR;
  const int tid = tidx(), lane = tid & 63, wid = tid >> 6, fr = lane & 15, fq = lane >> 4;
  const int b = u / 129, t0 = (u % 129) * 16;
  const int r0 = rowof(b, t0);
  const bf16_t* proj = (const bf16_t*)(p.ws + WS_PROJ);
  bf16_t* RW = (bf16_t*)(p.ws + WS_RW);
  bf16_t* SS = (bf16_t*)(p.ws + WS_SS);
  bf16_t* LR = (bf16_t*)(p.ws + WS_LR);
  bf16_t* RG = (bf16_t*)(p.ws + WS_RG);
  float* RC = (float*)(p.ws + WS_RC);
  float* SD = (float*)(p.ws + WS_SD);
  const int rm1 = (t0 > 0) ? rowof(b, t0 - 1) : 0, rm2 = (t0 > 0) ? rowof(b, t0 - 2) : 0, rm3 = (t0 > 0) ? rowof(b, t0 - 3) : 0;
  const float pz = (t0 > 0) ? 1.f : 0.f;
  half_barrier(smem);
  unsigned ra[2][17];
  unsigned rc[3][19];
  int coff[3];
#pragma unroll
  for (int q = 0; q < 2; ++q) {
    const int col = 2 * tid + q * 512;
    ra[q][0] = *reinterpret_cast<const unsigned*>(proj + (size_t)rm1 * PJ + OFF_RW + col);
#pragma unroll
    for (int tt = 0; tt < 16; ++tt) ra[q][1 + tt] = *reinterpret_cast<const unsigned*>(proj + (size_t)(r0 + tt) * PJ + OFF_RW + col);
  }
#pragma unroll
  for (int q = 0; q < 3; ++q) {
    const bool is_lru = (q == 2);
    const int pr = is_lru ? (tid & 127) : ((tid + q * 256) % 384);
    coff[q] = (is_lru ? OFF_LRU : OFF_XBC) + 2 * pr;
    rc[q][0] = *reinterpret_cast<const unsigned*>(proj + (size_t)rm3 * PJ + coff[q]);
    rc[q][1] = *reinterpret_cast<const unsigned*>(proj + (size_t)rm2 * PJ + coff[q]);
    rc[q][2] = *reinterpret_cast<const unsigned*>(proj + (size_t)rm1 * PJ + coff[q]);
#pragma unroll
    for (int tt = 0; tt < 16; ++tt) rc[q][3 + tt] = *reinterpret_cast<const unsigned*>(proj + (size_t)(r0 + tt) * PJ + coff[q]);
  }
  const bf16_t dtraw = proj[(size_t)(r0 + ((tid >> 2) & 15)) * PJ + OFF_DT + (tid & 3)];
  {
    const float* mu = p.in[14] + l * 1024;
#pragma unroll
    for (int q = 0; q < 2; ++q) {
      const int col = 2 * tid + q * 512;
      const float2 m = *reinterpret_cast<const float2*>(mu + col);
      const unsigned pw = ra[q][0];
      float p0 = pz * lo2f(pw), p1 = pz * hi2f(pw);
#pragma unroll
      for (int tt = 0; tt < 16; ++tt) {
        const unsigned cw_ = ra[q][1 + tt];
        const float c0 = lo2f(cw_), c1 = hi2f(cw_);
        const float v0 = c0 + (p0 - c0) * m.x, v1 = c1 + (p1 - c1) * m.y;
        p0 = c0; p1 = c1;
        if (q == 0) {
          *reinterpret_cast<float2*>(pm + tt * PMS + col) = make_float2(v0, v1);
        } else if (tid < 128) {
          *reinterpret_cast<unsigned*>(RW + (size_t)(r0 + tt) * 1536 + 1280 + 2 * tid) = pack2(v0, v1);
        } else {
          const int i = 2 * (tid - 128);
          float a0, a1;
          if (i < 64) { a0 = tanh_fast(v0); a1 = tanh_fast(v1); }
          else if (i < 128) { a0 = v0; a1 = v1; }
          else { a0 = sigmoidf_(v0); a1 = sigmoidf_(v1); }
          *reinterpret_cast<unsigned*>(latA + tt * LSTR + i) = pack2(a0, a1);
        }
      }
    }
  }
  {
#pragma unroll
    for (int q = 0; q < 3; ++q) {
      const bool is_lru = (q == 2);
      const int pr = is_lru ? tid : tid + q * 256;
      const bool act = is_lru ? (tid < 128) : (pr < 384);
      if (act) {
        const int ch = 2 * pr;
        const int C = is_lru ? 256 : 768;
        const float* cw = is_lru ? (p.in[25] + l * 4 * 256) : (p.in[8] + l * 4 * 768);
        const float2 cb = *reinterpret_cast<const float2*>((is_lru ? p.in[26] + l * 256 : p.in[9] + l * 768) + ch);
        const float2 w0 = *reinterpret_cast<const float2*>(cw + ch), w1 = *reinterpret_cast<const float2*>(cw + C + ch);
        const float2 w2 = *reinterpret_cast<const float2*>(cw + 2 * C + ch), w3 = *reinterpret_cast<const float2*>(cw + 3 * C + ch);
        const unsigned u0 = rc[q][0], u1 = rc[q][1], u2 = rc[q][2];
        float x0a = pz * lo2f(u0), x0b = pz * hi2f(u0), x1a = pz * lo2f(u1), x1b = pz * hi2f(u1), x2a = pz * lo2f(u2), x2b = pz * hi2f(u2);
#pragma unroll
        for (int tt = 0; tt < 16; ++tt) {
          const unsigned u3 = rc[q][3 + tt];
          const float x3a = lo2f(u3), x3b = hi2f(u3);
          const float ya = cb.x + w0.x * x0a + w1.x * x1a + w2.x * x2a + w3.x * x3a;
          const float yb = cb.y + w0.y * x0b + w1.y * x1b + w2.y * x2b + w3.y * x3b;
          if (is_lru) *reinterpret_cast<unsigned*>(xcA + tt * LSTR + ch) = pack2(ya, yb);
          else *reinterpret_cast<unsigned*>(SS + (size_t)(r0 + tt) * 768 + ch) = pack2(siluf_(ya), siluf_(yb));
          x0a = x1a; x0b = x1b; x1a = x2a; x1b = x2b; x2a = x3a; x2b = x3b;
        }
      }
    }
    if (tid < 64) {
      const int tt = tid >> 2, hh = tid & 3;
      const float v = bf2f(dtraw) + p.in[10][l * 4 + hh];
      SD[(size_t)(r0 + tt) * 4 + hh] = softplus_fast(v);
    }
  }
  half_barrier(smem);
  f32x4 accw[4], acca[4], accg[4], accr[4], acci[4];
#pragma unroll
  for (int mf = 0; mf < 4; ++mf) {
    accw[mf] = f32x4{0.f, 0.f, 0.f, 0.f}; acca[mf] = accw[mf]; accg[mf] = accw[mf]; accr[mf] = accw[mf]; acci[mf] = accw[mf];
  }
  {
    const bf16_t* W2T = (const bf16_t*)(p.ws + WS_W2T);
    const bf16_t* A2T = (const bf16_t*)(p.ws + WS_A2T);
    const bf16_t* G2T = (const bf16_t*)(p.ws + WS_G2T);
    const bf16_t* WAT = (const bf16_t*)(p.ws + WS_WAT);
    const bf16_t* WXT = (const bf16_t*)(p.ws + WS_WXT);
    bf16x8 al[8], ax[2];
#pragma unroll
    for (int ks = 0; ks < 8; ++ks) al[ks] = *reinterpret_cast<const bf16x8*>(latA + fr * LSTR + ks * 32 + fq * 8);
#pragma unroll
    for (int ks = 0; ks < 2; ++ks) ax[ks] = *reinterpret_cast<const bf16x8*>(xcA + fr * LSTR + wid * 64 + ks * 32 + fq * 8);
#pragma unroll
    for (int mf = 0; mf < 4; ++mf) {
      const int n = wid * 64 + mf * 16 + fr;
#pragma unroll
      for (int ks = 0; ks < 2; ++ks) {
        const bf16x8 bw = *reinterpret_cast<const bf16x8*>(W2T + n * 64 + ks * 32 + fq * 8);
        const bf16x8 ba = *reinterpret_cast<const bf16x8*>(A2T + n * 64 + ks * 32 + fq * 8);
        const bf16x8 br = *reinterpret_cast<const bf16x8*>(WAT + n * 64 + ks * 32 + fq * 8);
        const bf16x8 bi = *reinterpret_cast<const bf16x8*>(WXT + n * 64 + ks * 32 + fq * 8);
        accw[mf] = __builtin_amdgcn_mfma_f32_16x16x32_bf16(bw, al[ks], accw[mf], 0, 0, 0);
        acca[mf] = __builtin_amdgcn_mfma_f32_16x16x32_bf16(ba, al[2 + ks], acca[mf], 0, 0, 0);
        accr[mf] = __builtin_amdgcn_mfma_f32_16x16x32_bf16(br, ax[ks], accr[mf], 0, 0, 0);
        acci[mf] = __builtin_amdgcn_mfma_f32_16x16x32_bf16(bi, ax[ks], acci[mf], 0, 0, 0);
      }
#pragma unroll
      for (int ks = 0; ks < 4; ++ks) {
        const bf16x8 bg = *reinterpret_cast<const bf16x8*>(G2T + n * 128 + ks * 32 + fq * 8);
        accg[mf] = __builtin_amdgcn_mfma_f32_16x16x32_bf16(bg, al[4 + ks], accg[mf], 0, 0, 0);
      }
    }
  }
  {
    const int tt = fr;
    const size_t row = (size_t)(r0 + tt);
    float kkv[16], kpv[16], avv[16], rv[16];
    float ss = 0.f, cf = 0.f;
#pragma unroll
    for (int mf = 0; mf < 4; ++mf) {
      const int c = wid * 64 + mf * 16 + fq * 4;
      const float4 r4 = *reinterpret_cast<const float4*>(pm + tt * PMS + c);
      const float4 k4 = *reinterpret_cast<const float4*>(pm + tt * PMS + 256 + c);
      const float4 a0 = *reinterpret_cast<const float4*>(p.in[17] + l * 256 + c);
      const float4 kkc = *reinterpret_cast<const float4*>(p.in[20] + l * 256 + c);
      const float4 kac = *reinterpret_cast<const float4*>(p.in[21] + l * 256 + c);
      const float4 rkc = *reinterpret_cast<const float4*>(p.in[22] + l * 256 + c);
      const float rr_[4] = {r4.x, r4.y, r4.z, r4.w}, kk_[4] = {k4.x, k4.y, k4.z, k4.w};
      const float a0_[4] = {a0.x, a0.y, a0.z, a0.w}, kkc_[4] = {kkc.x, kkc.y, kkc.z, kkc.w};
      const float kac_[4] = {kac.x, kac.y, kac.z, kac.w}, rkc_[4] = {rkc.x, rkc.y, rkc.z, rkc.w};
#pragma unroll
      for (int j = 0; j < 4; ++j) {
        const int x = mf * 4 + j;
        rv[x] = rr_[j];
        avv[x] = sigmoidf_(a0_[j] + acca[mf][j]);
        kkv[x] = kk_[j] * kkc_[j];
        ss += kkv[x] * kkv[x];
        kpv[x] = kk_[j] * (1.f + (avv[x] - 1.f) * kac_[j]);
        cf += rv[x] * kpv[x] * rkc_[j];
      }
    }
    ss += __shfl_xor(ss, 16, 64); ss += __shfl_xor(ss, 32, 64);
    cf += __shfl_xor(cf, 16, 64); cf += __shfl_xor(cf, 32, 64);
    const float inv = 1.f / fmaxf(sqrtf(ss), 1e-12f);
    float4 w0a[4], baa[4], bxa[4], lama[4];
#pragma unroll
    for (int mf = 0; mf < 4; ++mf) {
      const int c = wid * 64 + mf * 16 + fq * 4;
      w0a[mf] = *reinterpret_cast<const float4*>(p.in[15] + l * 256 + c);
      baa[mf] = *reinterpret_cast<const float4*>(p.in[28] + l * 256 + c);
      bxa[mf] = *reinterpret_cast<const float4*>(p.in[30] + l * 256 + c);
      lama[mf] = *reinterpret_cast<const float4*>(p.in[31] + l * 256 + c);
    }
    if (fq == 0) RC[row * 4 + wid] = cf;
#pragma unroll
    for (int mf = 0; mf < 4; ++mf) {
      const int c = wid * 64 + mf * 16 + fq * 4;
      const float4 w0 = w0a[mf], ba = baa[mf], bx = bxa[mf], lam = lama[mf];
      const float w0_[4] = {w0.x, w0.y, w0.z, w0.w}, ba_[4] = {ba.x, ba.y, ba.z, ba.w};
      const float bx_[4] = {bx.x, bx.y, bx.z, bx.w}, lam_[4] = {lam.x, lam.y, lam.z, lam.w};
      const uint2 xcr = *reinterpret_cast<const uint2*>(xcA + tt * LSTR + c);
      const float xc_[4] = {lo2f(xcr.x), hi2f(xcr.x), lo2f(xcr.y), hi2f(xcr.y)};
      float omw[4], kn[4], bb[4], la[4], uu[4];
#pragma unroll
      for (int j = 0; j < 4; ++j) {
        const int x = mf * 4 + j;
        const float wv = w0_[j] + accw[mf][j];
        const float w = -softplus_fast(-wv) - 0.5f;
        omw[j] = 1.f - __expf(-__expf(w));
        kn[j] = kkv[x] * inv;
        bb[j] = kn[j] * avv[x];
        const float rr = sigmoidf_(accr[mf][j] + ba_[j]), ii = sigmoidf_(acci[mf][j] + bx_[j]);
        la[j] = -8.f * rr * softplus_fast(-lam_[j]);
        uu[j] = sqrtf(fmaxf(1.f - __expf(2.f * la[j]), 0.f)) * (ii * xc_[j]);
      }
      bf16_t* o = RW + row * 1536 + c;
      *reinterpret_cast<uint2*>(o) = make_uint2(pack2(omw[0], omw[1]), pack2(omw[2], omw[3]));
      *reinterpret_cast<uint2*>(o + 256) = make_uint2(pack2(kn[0], kn[1]), pack2(kn[2], kn[3]));
      *reinterpret_cast<uint2*>(o + 512) = make_uint2(pack2(bb[0], bb[1]), pack2(bb[2], bb[3]));
      *reinterpret_cast<uint2*>(o + 768) = make_uint2(pack2(kpv[mf * 4], kpv[mf * 4 + 1]), pack2(kpv[mf * 4 + 2], kpv[mf * 4 + 3]));
      *reinterpret_cast<uint2*>(o + 1024) = make_uint2(pack2(rv[mf * 4], rv[mf * 4 + 1]), pack2(rv[mf * 4 + 2], rv[mf * 4 + 3]));
      *reinterpret_cast<uint2*>(RG + row * 256 + c) = make_uint2(pack2(accg[mf][0], accg[mf][1]), pack2(accg[mf][2], accg[mf][3]));
      *reinterpret_cast<uint2*>(LR + row * 512 + c) = make_uint2(pack2(la[0], la[1]), pack2(la[2], la[3]));
      *reinterpret_cast<uint2*>(LR + row * 512 + 256 + c) = make_uint2(pack2(uu[0], uu[1]), pack2(uu[2], uu[3]));
    }
  }
}

__device__ __forceinline__ void rwkv_scan_unit(CP p, int u, char* smem) {
  float* buf = (float*)smem;
  const int tid = tidx(), wid = tid >> 6, lane = tid & 63, i = lane >> 4, j = lane & 15;
  const int b = u >> 4, h = (u >> 2) & 3, q = u & 3;
  const int rowv = q * 16 + wid * 4 + i;
  const bf16_t* RW = (const bf16_t*)(p.ws + WS_RW);
  bf16_t* Y = (bf16_t*)(p.ws + WS_Y);
  float s0 = 0.f, s1 = 0.f, s2 = 0.f, s3 = 0.f;
  uint4 st[3];
  auto gload = [&](int c) {
    const int rb = rowof(b, c * 16);
#pragma unroll
    for (int x = 0; x < 3; ++x) {
      const int e = tid + x * 256, tok = e / 48, rem = e % 48, vec = rem >> 3, part = rem & 7;
      st[x] = *reinterpret_cast<const uint4*>(RW + (size_t)(rb + tok) * 1536 + vec * 256 + h * 64 + part * 8);
    }
  };
  auto lwrite = [&](int bi) {
#pragma unroll
    for (int x = 0; x < 3; ++x) {
      const int e = tid + x * 256, tok = e / 48, rem = e % 48, vec = rem >> 3, part = rem & 7;
      float* d = buf + bi * 6144 + tok * 384 + vec * 64 + part * 8;
      *reinterpret_cast<float4*>(d) = make_float4(lo2f(st[x].x), hi2f(st[x].x), lo2f(st[x].y), hi2f(st[x].y));
      *reinterpret_cast<float4*>(d + 4) = make_float4(lo2f(st[x].z), hi2f(st[x].z), lo2f(st[x].w), hi2f(st[x].w));
    }
  };
  half_barrier(smem);
  gload(0);
  lwrite(0);
  half_barrier(smem);
  constexpr int NCH = T / 16;
  for (int c = 0; c < NCH; ++c) {
    if (c + 1 < NCH) gload(c + 1);
    const float* cb = buf + (c & 1) * 6144;
    float ykeep = 0.f;
    float4 om = *reinterpret_cast<const float4*>(cb + j * 4);
    float4 kk = *reinterpret_cast<const float4*>(cb + 64 + j * 4);
    float4 bb = *reinterpret_cast<const float4*>(cb + 128 + j * 4);
    float4 kp = *reinterpret_cast<const float4*>(cb + 192 + j * 4);
    float4 rr = *reinterpret_cast<const float4*>(cb + 256 + j * 4);
    float vv = cb[320 + rowv];
#pragma unroll 2
    for (int s = 0; s < 16; ++s) {
      const float* sb = cb + (s + 1) * 384;
      const float4 om_n = *reinterpret_cast<const float4*>(sb + j * 4);
      const float4 kk_n = *reinterpret_cast<const float4*>(sb + 64 + j * 4);
      const float4 bb_n = *reinterpret_cast<const float4*>(sb + 128 + j * 4);
      const float4 kp_n = *reinterpret_cast<const float4*>(sb + 192 + j * 4);
      const float4 rr_n = *reinterpret_cast<const float4*>(sb + 256 + j * 4);
      const float vv_n = sb[320 + rowv];
      __builtin_amdgcn_sched_barrier(0);
      float d = s0 * kk.x + s1 * kk.y + s2 * kk.z + s3 * kk.w;
      d = allreduce16(d);
      const float sa = -d;
      s0 = fmaf(-s0, om.x, s0); s1 = fmaf(-s1, om.y, s1); s2 = fmaf(-s2, om.z, s2); s3 = fmaf(-s3, om.w, s3);
      s0 = fmaf(sa, bb.x, s0); s1 = fmaf(sa, bb.y, s1); s2 = fmaf(sa, bb.z, s2); s3 = fmaf(sa, bb.w, s3);
      s0 = fmaf(vv, kp.x, s0); s1 = fmaf(vv, kp.y, s1); s2 = fmaf(vv, kp.z, s2); s3 = fmaf(vv, kp.w, s3);
      float y = s0 * rr.x + s1 * rr.y + s2 * rr.z + s3 * rr.w;
      y = allreduce16(y);
      if (j == s) ykeep = y;
      om = om_n; kk = kk_n; bb = bb_n; kp = kp_n; rr = rr_n; vv = vv_n;
    }
    Y[(size_t)(rowof(b, c * 16) + j) * 1024 + 256 + h * 64 + rowv] = f2bf(ykeep);
    if (c + 1 < NCH) lwrite((c + 1) & 1);
    half_barrier(smem);
  }
}

__device__ __forceinline__ void ssd_scan_unit(CP p, int l, int u, char* smem) {
  constexpr int SST = 296;
  float* buf = (float*)smem;
  const int tid = tidx(), wid = tid >> 6, lane = tid & 63, i = lane >> 4, j = lane & 15;
  const int b = u >> 4, h = (u >> 2) & 3, q = u & 3, g = h >> 1;
  const int prow = wid * 4 + i;
  const bf16_t* SS = (const bf16_t*)(p.ws + WS_SS);
  const float* SD = (const float*)(p.ws + WS_SD);
  bf16_t* Y = (bf16_t*)(p.ws + WS_Y);
  const float Ah = -__expf(p.in[11][l * 4 + h]);
  const float Dh = p.in[12][l * 4 + h];
  float hs[8];
#pragma unroll
  for (int n = 0; n < 8; ++n) hs[n] = 0.f;
  uint4 st[2];
  unsigned short stxr = 0;
  float stdt = 0.f;
  auto gload = [&](int c) {
    const int rb = rowof(b, c * 16);
#pragma unroll
    for (int x = 0; x < 2; ++x) {
      const int e = tid + x * 256, tok = e >> 5, rem = e & 31, which = rem >> 4, part = rem & 15;
      st[x] = *reinterpret_cast<const uint4*>(SS + (size_t)(rb + tok) * 768 + 256 + which * 256 + g * 128 + part * 8);
    }
    {
      const int tok = tid >> 4, pp = tid & 15;
      stxr = SS[(size_t)(rb + tok) * 768 + h * 64 + q * 16 + pp];
      stdt = SD[(size_t)(rb + tok) * 4 + h];
    }
  };
  auto lwrite = [&](int bi) {
#pragma unroll
    for (int x = 0; x < 2; ++x) {
      const int e = tid + x * 256, tok = e >> 5, rem = e & 31, which = rem >> 4, part = rem & 15;
      float* d = buf + bi * 16 * SST + tok * SST + which * 128 + part * 8;
      *reinterpret_cast<float4*>(d) = make_float4(lo2f(st[x].x), hi2f(st[x].x), lo2f(st[x].y), hi2f(st[x].y));
      *reinterpret_cast<float4*>(d + 4) = make_float4(lo2f(st[x].z), hi2f(st[x].z), lo2f(st[x].w), hi2f(st[x].w));
    }
    {
      const int tok = tid >> 4, pp = tid & 15;
      float* d = buf + bi * 16 * SST + tok * SST;
      const float stx = bf2f(stxr);
      d[256 + pp] = stx * stdt;
      d[272 + pp] = stx;
      if (pp == 0) d[288] = __expf(stdt * Ah);
    }
  };
  half_barrier(smem);
  gload(0);
  lwrite(0);
  half_barrier(smem);
  constexpr int NCH = T / 16;
  for (int c = 0; c < NCH; ++c) {
    if (c + 1 < NCH) gload(c + 1);
    const float* cb = buf + (c & 1) * 16 * SST;
    float ykeep = 0.f;
    float4 B0 = *reinterpret_cast<const float4*>(cb + j * 4), B1 = *reinterpret_cast<const float4*>(cb + 64 + j * 4);
    float4 C0 = *reinterpret_cast<const float4*>(cb + 128 + j * 4), C1 = *reinterpret_cast<const float4*>(cb + 192 + j * 4);
    float xdt = cb[256 + prow], xr = cb[272 + prow], a = cb[288];
#pragma unroll 2
    for (int s = 0; s < 16; ++s) {
      const float* sb = cb + (s + 1) * SST;
      const float4 B0n = *reinterpret_cast<const float4*>(sb + j * 4), B1n = *reinterpret_cast<const float4*>(sb + 64 + j * 4);
      const float4 C0n = *reinterpret_cast<const float4*>(sb + 128 + j * 4), C1n = *reinterpret_cast<const float4*>(sb + 192 + j * 4);
      const float xdtn = sb[256 + prow], xrn = sb[272 + prow], an = sb[288];
      __builtin_amdgcn_sched_barrier(0);
      hs[0] = fmaf(a, hs[0], xdt * B0.x); hs[1] = fmaf(a, hs[1], xdt * B0.y); hs[2] = fmaf(a, hs[2], xdt * B0.z); hs[3] = fmaf(a, hs[3], xdt * B0.w);
      hs[4] = fmaf(a, hs[4], xdt * B1.x); hs[5] = fmaf(a, hs[5], xdt * B1.y); hs[6] = fmaf(a, hs[6], xdt * B1.z); hs[7] = fmaf(a, hs[7], xdt * B1.w);
      float y = hs[0] * C0.x + hs[1] * C0.y + hs[2] * C0.z + hs[3] * C0.w + hs[4] * C1.x + hs[5] * C1.y + hs[6] * C1.z + hs[7] * C1.w;
      y = allreduce16(y);
      y = fmaf(Dh, xr, y);
      if (j == s) ykeep = y;
      B0 = B0n; B1 = B1n; C0 = C0n; C1 = C1n; xdt = xdtn; xr = xrn; a = an;
    }
    Y[(size_t)(rowof(b, c * 16) + j) * 1024 + h * 64 + q * 16 + prow] = f2bf(ykeep);
    if (c + 1 < NCH) lwrite((c + 1) & 1);
    half_barrier(smem);
  }
}

__device__ __forceinline__ void ret_scan_unit(CP p, int l, int u, char* smem) {
  float* buf = (float*)smem;
  float* ybuf0 = buf + 2 * 16 * 128;
  const int tid = tidx(), e = tid >> 2, dsl = tid & 3;
  const int b = u >> 2, h = u & 3;
  const bf16_t* proj = (const bf16_t*)(p.ws + WS_PROJ);
  const float* rope = (const float*)(p.ws + WS_ROPE);
  bf16_t* Y = (bf16_t*)(p.ws + WS_Y);
  const float gdec = 1.f - exp2f(-5.f - (float)h);
  float S[8];
#pragma unroll
  for (int n = 0; n < 8; ++n) S[n] = 0.f;
  const int stok = tid >> 4, spart = tid & 15;
  uint4 sa_, sb_;
  float4 rp0, rp1, rp2, rp3;
  uint2 gg_n, gg_c;
  const int s_qk = (spart >> 2) & 1, s_pp = spart & 3;
  const int offa = (spart < 8) ? (OFF_RET + s_qk * 128 + h * 32 + s_pp * 8) : (OFF_RET + 256 + h * 64 + (spart - 8) * 8);
  const int offb = (spart < 8) ? (OFF_RET + s_qk * 128 + h * 32 + (s_pp ^ 2) * 8) : offa;
  const int ech = h * 64 + spart * 4;
  const float4 gw = *reinterpret_cast<const float4*>(p.in[32] + l * 256 + ech);
  auto gload = [&](int c) {
    const size_t row = (size_t)(rowof(b, c * 16) + stok);
    sa_ = *reinterpret_cast<const uint4*>(proj + row * PJ + offa);
    sb_ = *reinterpret_cast<const uint4*>(proj + row * PJ + offb);
    const float* rpp = rope + ((size_t)(c * 16 + stok) * 16 + (s_pp & 1) * 8) * 2;
    rp0 = *reinterpret_cast<const float4*>(rpp);
    rp1 = *reinterpret_cast<const float4*>(rpp + 4);
    rp2 = *reinterpret_cast<const float4*>(rpp + 8);
    rp3 = *reinterpret_cast<const float4*>(rpp + 12);
    gg_n = *reinterpret_cast<const uint2*>(proj + row * PJ + OFF_RET + 512 + ech);
  };
  auto lwrite = [&](int bi) {
    float* d = buf + bi * 2048 + stok * 128;
    float a[8];
    a[0] = lo2f(sa_.x); a[1] = hi2f(sa_.x); a[2] = lo2f(sa_.y); a[3] = hi2f(sa_.y);
    a[4] = lo2f(sa_.z); a[5] = hi2f(sa_.z); a[6] = lo2f(sa_.w); a[7] = hi2f(sa_.w);
    if (spart < 8) {
      float o[8];
      o[0] = lo2f(sb_.x); o[1] = hi2f(sb_.x); o[2] = lo2f(sb_.y); o[3] = hi2f(sb_.y);
      o[4] = lo2f(sb_.z); o[5] = hi2f(sb_.z); o[6] = lo2f(sb_.w); o[7] = hi2f(sb_.w);
      const float cs[16] = {rp0.x, rp0.y, rp0.z, rp0.w, rp1.x, rp1.y, rp1.z, rp1.w, rp2.x, rp2.y, rp2.z, rp2.w, rp3.x, rp3.y, rp3.z, rp3.w};
      const float sc = s_qk ? 0.17677669529663687f : 1.f;
      float r[8];
#pragma unroll
      for (int n = 0; n < 8; ++n) {
        r[n] = (s_pp < 2) ? (a[n] * cs[2 * n] - o[n] * cs[2 * n + 1]) : (o[n] * cs[2 * n + 1] + a[n] * cs[2 * n]);
        r[n] *= sc;
      }
      float* dd = d + s_qk * 32 + s_pp * 8;
      *reinterpret_cast<float4*>(dd) = make_float4(r[0], r[1], r[2], r[3]);
      *reinterpret_cast<float4*>(dd + 4) = make_float4(r[4], r[5], r[6], r[7]);
    } else {
      float* dd = d + 64 + (spart - 8) * 8;
      *reinterpret_cast<float4*>(dd) = make_float4(a[0], a[1], a[2], a[3]);
      *reinterpret_cast<float4*>(dd + 4) = make_float4(a[4], a[5], a[6], a[7]);
    }
  };
  half_barrier(smem);
  gload(0);
  lwrite(0);
  gg_c = gg_n;
  half_barrier(smem);
  constexpr int NCH = T / 16;
  for (int c = 0; c < NCH; ++c) {
    if (c + 1 < NCH) gload(c + 1);
    const float* cb = buf + (c & 1) * 2048;
    float* ybuf = ybuf0 + (c & 1) * 1024;
    float4 q0 = *reinterpret_cast<const float4*>(cb + dsl * 8), q1 = *reinterpret_cast<const float4*>(cb + dsl * 8 + 4);
    float4 k0 = *reinterpret_cast<const float4*>(cb + 32 + dsl * 8), k1 = *reinterpret_cast<const float4*>(cb + 32 + dsl * 8 + 4);
    float v = cb[64 + e];
#pragma unroll 2
    for (int s = 0; s < 16; ++s) {
      const float* sb = cb + (s + 1) * 128;
      const float4 q0n = *reinterpret_cast<const float4*>(sb + dsl * 8), q1n = *reinterpret_cast<const float4*>(sb + dsl * 8 + 4);
      const float4 k0n = *reinterpret_cast<const float4*>(sb + 32 + dsl * 8), k1n = *reinterpret_cast<const float4*>(sb + 32 + dsl * 8 + 4);
      const float vn = sb[64 + e];
      __builtin_amdgcn_sched_barrier(0);
      S[0] = fmaf(gdec, S[0], k0.x * v); S[1] = fmaf(gdec, S[1], k0.y * v); S[2] = fmaf(gdec, S[2], k0.z * v); S[3] = fmaf(gdec, S[3], k0.w * v);
      S[4] = fmaf(gdec, S[4], k1.x * v); S[5] = fmaf(gdec, S[5], k1.y * v); S[6] = fmaf(gdec, S[6], k1.z * v); S[7] = fmaf(gdec, S[7], k1.w * v);
      float y = S[0] * q0.x + S[1] * q0.y + S[2] * q0.z + S[3] * q0.w + S[4] * q1.x + S[5] * q1.y + S[6] * q1.z + S[7] * q1.w;
      y = allreduce4(y);
      ybuf[s * 64 + e] = y;
      q0 = q0n; q1 = q1n; k0 = k0n; k1 = k1n; v = vn;
    }
    if (c + 1 < NCH) lwrite((c + 1) & 1);
    half_barrier(smem);
    {
      const float4 yv = *reinterpret_cast<const float4*>(ybuf + stok * 64 + spart * 4);
      const float mu = allreduce16(yv.x + yv.y + yv.z + yv.w) * (1.f / 64.f);
      const float d0 = yv.x - mu, d1 = yv.y - mu, d2 = yv.z - mu, d3 = yv.w - mu;
      const float var = allreduce16(d0 * d0 + d1 * d1 + d2 * d2 + d3 * d3) * (1.f / 64.f);
      const float rs = rsqrtf(var + 1e-5f);
      const size_t row = (size_t)(rowof(b, c * 16) + stok);
      uint2 o;
      o.x = pack2(d0 * rs * gw.x * siluf_(lo2f(gg_c.x)), d1 * rs * gw.y * siluf_(hi2f(gg_c.x)));
      o.y = pack2(d2 * rs * gw.z * siluf_(lo2f(gg_c.y)), d3 * rs * gw.w * siluf_(hi2f(gg_c.y)));
      *reinterpret_cast<uint2*>(Y + row * 1024 + 768 + ech) = o;
    }
    gg_c = gg_n;
  }
}


__device__ __forceinline__ void ret_mfma_unit(CP p, int l, int u, char* smem) {
  const int tid = tidx(), wv = tid >> 6, lane = tid & 63, r = lane & 15, fq = lane >> 4;
  const int bh = u * 2 + (wv >> 1), b = bh >> 2, h = bh & 3, eh = wv & 1;
  char* wl = smem + wv * 8192;
  bf16_t* KT = (bf16_t*)wl;
  bf16_t* VT = (bf16_t*)(wl + 1024);
  bf16_t* PT = (bf16_t*)(wl + 3072);
  bf16_t* ST = (bf16_t*)(wl + 4096);
  const bf16_t* proj = (const bf16_t*)(p.ws + WS_PROJ);
  const float* rope = (const float*)(p.ws + WS_ROPE);
  bf16_t* Y = (bf16_t*)(p.ws + WS_Y);
  half_barrier(smem);
  for (int i = lane; i < 512; i += 64) reinterpret_cast<unsigned*>(ST)[i] = 0u;
  const float lg = log2f(1.f - exp2f(-5.f - (float)h));
  const float dk = exp2f(lg * (float)(15 - r)), dq = exp2f(lg * (float)(r + 1)), d16 = exp2f(lg * 16.f);
  float pw[4];
#pragma unroll
  for (int jj = 0; jj < 4; ++jj) { const int t = fq * 4 + jj; pw[jj] = (r <= t) ? exp2f(lg * (float)(t - r)) : 0.f; }
  f32x4 Sacc[2][2];
#pragma unroll
  for (int mf = 0; mf < 2; ++mf)
#pragma unroll
    for (int nf = 0; nf < 2; ++nf) Sacc[mf][nf] = f32x4{0.f, 0.f, 0.f, 0.f};
  const bf16x8 zero8 = {0, 0, 0, 0, 0, 0, 0, 0};
  const bool lowk = fq < 2;
  uint4 qa, qb, ka, kb, v0, nqa, nqb, nka, nkb, nv0, mqa, mqb, mka, mkb, mv0;
  float4 rp0, rp1, rp2, rp3, nrp0, nrp1, nrp2, nrp3;
  constexpr int NCH = T / 16;
#define RET_GLOAD(c, QA, QB, KA, KB, V0) do { \
    const bf16_t* pr_ = proj + (size_t)(rowof(b, (c) * 16) + r) * PJ + OFF_RET; \
    QA = *reinterpret_cast<const uint4*>(pr_ + h * 32 + fq * 8); \
    QB = *reinterpret_cast<const uint4*>(pr_ + h * 32 + (fq ^ 2) * 8); \
    KA = *reinterpret_cast<const uint4*>(pr_ + 128 + h * 32 + fq * 8); \
    KB = *reinterpret_cast<const uint4*>(pr_ + 128 + h * 32 + (fq ^ 2) * 8); \
    V0 = *reinterpret_cast<const uint4*>(pr_ + 256 + h * 64 + eh * 32 + fq * 8); \
  } while (0)
#define RET_ROPE(c, R0, R1, R2, R3) do { \
    const float* rq_ = rope + ((size_t)((c) * 16 + r) * 16 + (fq & 1) * 8) * 2; \
    R0 = *reinterpret_cast<const float4*>(rq_); R1 = *reinterpret_cast<const float4*>(rq_ + 4); \
    R2 = *reinterpret_cast<const float4*>(rq_ + 8); R3 = *reinterpret_cast<const float4*>(rq_ + 12); \
  } while (0)
  RET_GLOAD(0, qa, qb, ka, kb, v0);
  RET_ROPE(0, rp0, rp1, rp2, rp3);
  RET_GLOAD(1, nqa, nqb, nka, nkb, nv0);
  for (int c = 0; c < NCH; ++c) {
    RET_GLOAD((c + 2 < NCH) ? c + 2 : c, mqa, mqb, mka, mkb, mv0);
    RET_ROPE((c + 1 < NCH) ? c + 1 : c, nrp0, nrp1, nrp2, nrp3);
    const float cs[16] = {rp0.x, rp0.y, rp0.z, rp0.w, rp1.x, rp1.y, rp1.z, rp1.w, rp2.x, rp2.y, rp2.z, rp2.w, rp3.x, rp3.y, rp3.z, rp3.w};
    const unsigned qaw[4] = {qa.x, qa.y, qa.z, qa.w}, qbw[4] = {qb.x, qb.y, qb.z, qb.w};
    const unsigned kaw[4] = {ka.x, ka.y, ka.z, ka.w}, kbw[4] = {kb.x, kb.y, kb.z, kb.w};
    float qf[8], kf[8];
#pragma unroll
    for (int n = 0; n < 8; ++n) {
      const float qo = (n & 1) ? hi2f(qaw[n >> 1]) : lo2f(qaw[n >> 1]);
      const float qp = (n & 1) ? hi2f(qbw[n >> 1]) : lo2f(qbw[n >> 1]);
      const float ko = (n & 1) ? hi2f(kaw[n >> 1]) : lo2f(kaw[n >> 1]);
      const float kp = (n & 1) ? hi2f(kbw[n >> 1]) : lo2f(kbw[n >> 1]);
      const float cc = cs[2 * n], sn = cs[2 * n + 1];
      qf[n] = lowk ? (qo * cc - qp * sn) : (qp * sn + qo * cc);
      kf[n] = (lowk ? (ko * cc - kp * sn) : (kp * sn + ko * cc)) * 0.17677669529663687f;
    }
    bf16x8 Qf, Kf, Qs;
#pragma unroll
    for (int n = 0; n < 8; ++n) { Qf[n] = (short)f2bf(qf[n]); Kf[n] = (short)f2bf(kf[n]); Qs[n] = (short)f2bf(qf[n] * dq); }
    f32x4 P = __builtin_amdgcn_mfma_f32_16x16x32_bf16(Qf, Kf, f32x4{0.f, 0.f, 0.f, 0.f}, 0, 0, 0);
#pragma unroll
    for (int jj = 0; jj < 4; ++jj) PT[(fq * 4 + jj) * 16 + r] = f2bf(P[jj] * pw[jj]);
#pragma unroll
    for (int n = 0; n < 8; ++n) KT[(fq * 8 + n) * 16 + r] = f2bf(kf[n] * dk);
    {
      const unsigned vw[4] = {v0.x, v0.y, v0.z, v0.w};
#pragma unroll
      for (int i = 0; i < 8; ++i) VT[(fq * 8 + i) * 16 + r] = (bf16_t)((i & 1) ? (vw[i >> 1] >> 16) : (vw[i >> 1] & 0xffffu));
    }
    asm volatile("s_waitcnt lgkmcnt(0)" ::: "memory");
    bf16x8 Pf = *reinterpret_cast<const bf16x8*>(PT + r * 16 + (fq & 1) * 8);
    Pf = lowk ? Pf : zero8;
    bf16x8 VTf[2], STf[2], KTf[2];
#pragma unroll
    for (int nf = 0; nf < 2; ++nf) {
      VTf[nf] = *reinterpret_cast<const bf16x8*>(VT + (nf * 16 + r) * 16 + (fq & 1) * 8);
      VTf[nf] = lowk ? VTf[nf] : zero8;
      STf[nf] = *reinterpret_cast<const bf16x8*>(ST + (nf * 16 + r) * 32 + fq * 8);
    }
#pragma unroll
    for (int mf = 0; mf < 2; ++mf) {
      KTf[mf] = *reinterpret_cast<const bf16x8*>(KT + (mf * 16 + r) * 16 + (fq & 1) * 8);
      KTf[mf] = lowk ? KTf[mf] : zero8;
    }
    asm volatile("s_waitcnt lgkmcnt(0)" ::: "memory");
    f32x4 Yv[2];
#pragma unroll
    for (int nf = 0; nf < 2; ++nf) {
      Yv[nf] = __builtin_amdgcn_mfma_f32_16x16x32_bf16(Qs, STf[nf], f32x4{0.f, 0.f, 0.f, 0.f}, 0, 0, 0);
      Yv[nf] = __builtin_amdgcn_mfma_f32_16x16x32_bf16(Pf, VTf[nf], Yv[nf], 0, 0, 0);
    }
#pragma unroll
    for (int mf = 0; mf < 2; ++mf)
#pragma unroll
      for (int nf = 0; nf < 2; ++nf) {
        Sacc[mf][nf] = Sacc[mf][nf] * d16;
        Sacc[mf][nf] = __builtin_amdgcn_mfma_f32_16x16x32_bf16(KTf[mf], VTf[nf], Sacc[mf][nf], 0, 0, 0);
        *reinterpret_cast<uint2*>(ST + (nf * 16 + r) * 32 + mf * 16 + fq * 4) =
            make_uint2(pack2(Sacc[mf][nf][0], Sacc[mf][nf][1]), pack2(Sacc[mf][nf][2], Sacc[mf][nf][3]));
      }
    const int rb = rowof(b, c * 16);
#pragma unroll
    for (int jj = 0; jj < 4; ++jj)
#pragma unroll
      for (int nf = 0; nf < 2; ++nf)
        Y[(size_t)(rb + fq * 4 + jj) * 1024 + 768 + h * 64 + eh * 32 + nf * 16 + r] = f2bf(Yv[nf][jj]);
    asm volatile("s_waitcnt lgkmcnt(0)" ::: "memory");
    qa = nqa; qb = nqb; ka = nka; kb = nkb; v0 = nv0;
    nqa = mqa; nqb = mqb; nka = mka; nkb = mkb; nv0 = mv0;
    rp0 = nrp0; rp1 = nrp1; rp2 = nrp2; rp3 = nrp3;
  }
#undef RET_ROPE
#undef RET_GLOAD
}

__device__ __forceinline__ float gelu_tanh(float x) {
  const float u = 0.7978845608028654f * (x + 0.044715f * x * x * x);
  return 0.5f * x * (1.f + tanhf(u));
}
__device__ __forceinline__ void lru_scan_unit(CP p, int u, char* smem) {
  float* segS = (float*)smem;
  float* segH = segS + 256;
  const int tid = tidx(), seg = tid >> 6, lane = tid & 63;
  const int b = u >> 2, ch = (u & 3) * 64 + lane;
  const bf16_t* LR = (const bf16_t*)(p.ws + WS_LR);
  const bf16_t* proj = (const bf16_t*)(p.ws + WS_PROJ);
  bf16_t* Y = (bf16_t*)(p.ws + WS_Y);
  constexpr int SEGL = T / 4;
  const int tb = seg * SEGL;
  half_barrier(smem);
  constexpr int LB = 12, NBAT = SEGL / LB;
  float hl = 0.f, S = 0.f;
  {
    unsigned short la[LB], uu[LB], lan[LB], uun[LB];
#pragma unroll
    for (int x = 0; x < LB; ++x) {
      const size_t row = (size_t)rowof(b, tb + x);
      la[x] = LR[row * 512 + ch]; uu[x] = LR[row * 512 + 256 + ch];
    }
    for (int k = 0; k < NBAT; ++k) {
      const int tn = tb + (k + 1 < NBAT ? k + 1 : k) * LB;
#pragma unroll
      for (int x = 0; x < LB; ++x) {
        const size_t row = (size_t)rowof(b, tn + x);
        lan[x] = LR[row * 512 + ch]; uun[x] = LR[row * 512 + 256 + ch];
      }
#pragma unroll
      for (int x = 0; x < LB; ++x) {
        const float l_ = bf2f(la[x]);
        hl = fmaf(__expf(l_), hl, bf2f(uu[x]));
        S += l_;
      }
#pragma unroll
      for (int x = 0; x < LB; ++x) { la[x] = lan[x]; uu[x] = uun[x]; }
    }
  }
  segS[seg * 64 + lane] = S;
  segH[seg * 64 + lane] = hl;
  half_barrier(smem);
  float hh = 0.f;
  for (int q = 0; q < seg; ++q) hh = fmaf(__expf(segS[q * 64 + lane]), hh, segH[q * 64 + lane]);
  {
    unsigned short la[LB], uu[LB], gb[LB], lan[LB], uun[LB], gbn[LB];
#pragma unroll
    for (int x = 0; x < LB; ++x) {
      const size_t row = (size_t)rowof(b, tb + x);
      la[x] = LR[row * 512 + ch]; uu[x] = LR[row * 512 + 256 + ch]; gb[x] = proj[row * PJ + OFF_LRU + 256 + ch];
    }
    for (int k = 0; k < NBAT; ++k) {
      const int tn = tb + (k + 1 < NBAT ? k + 1 : k) * LB;
#pragma unroll
      for (int x = 0; x < LB; ++x) {
        const size_t row = (size_t)rowof(b, tn + x);
        lan[x] = LR[row * 512 + ch]; uun[x] = LR[row * 512 + 256 + ch]; gbn[x] = proj[row * PJ + OFF_LRU + 256 + ch];
      }
#pragma unroll
      for (int x = 0; x < LB; ++x) {
        hh = fmaf(__expf(bf2f(la[x])), hh, bf2f(uu[x]));
        Y[(size_t)rowof(b, tb + k * LB + x) * 1024 + 512 + ch] = f2bf(hh * gelu_tanh(bf2f(gb[x])));
      }
#pragma unroll
      for (int x = 0; x < LB; ++x) { la[x] = lan[x]; uu[x] = uun[x]; gb[x] = gbn[x]; }
    }
  }
}

__device__ __forceinline__ void epi_phase(CP p, int l) {
  const int tid_ = tidx(); const int lane = tid_ & 63, gw = bidx() * 4 + (tid_ >> 6), nw = nvb() * 4;
  const bf16_t* proj = (const bf16_t*)(p.ws + WS_PROJ);
  const bf16_t* RW = (const bf16_t*)(p.ws + WS_RW);
  const bf16_t* RG = (const bf16_t*)(p.ws + WS_RG);
  const float* RC = (const float*)(p.ws + WS_RC);
  bf16_t* Y = (bf16_t*)(p.ws + WS_Y);
  const int c = lane * 4;
  const float4 nw4 = *reinterpret_cast<const float4*>(p.in[13] + l * 256 + c);
  const float4 lw4 = *reinterpret_cast<const float4*>(p.in[23] + l * 256 + c);
  const float4 lb4 = *reinterpret_cast<const float4*>(p.in[24] + l * 256 + c);
  for (int row = gw; row < R; row += nw) {
    {
      const uint2 yr = *reinterpret_cast<const uint2*>(Y + (size_t)row * 1024 + c);
      const uint2 zr = *reinterpret_cast<const uint2*>(proj + (size_t)row * PJ + OFF_Z + c);
      const float y0 = lo2f(yr.x) * siluf_(lo2f(zr.x)), y1 = hi2f(yr.x) * siluf_(hi2f(zr.x));
      const float y2 = lo2f(yr.y) * siluf_(lo2f(zr.y)), y3 = hi2f(yr.y) * siluf_(hi2f(zr.y));
      float ss = y0 * y0 + y1 * y1 + y2 * y2 + y3 * y3;
#pragma unroll
      for (int o = 16; o >= 1; o >>= 1) ss += __shfl_xor(ss, o, 64);
      const float rs = rsqrtf(ss * (1.f / 128.f) + EPS);
      uint2 o;
      o.x = pack2(y0 * rs * nw4.x, y1 * rs * nw4.y);
      o.y = pack2(y2 * rs * nw4.z, y3 * rs * nw4.w);
      *reinterpret_cast<uint2*>(Y + (size_t)row * 1024 + c) = o;
    }
    {
      const uint2 yr = *reinterpret_cast<const uint2*>(Y + (size_t)row * 1024 + 768 + c);
      const uint2 gr = *reinterpret_cast<const uint2*>(proj + (size_t)row * PJ + OFF_RET + 512 + c);
      const float4 gw = *reinterpret_cast<const float4*>(p.in[32] + l * 256 + c);
      const float y0 = lo2f(yr.x), y1 = hi2f(yr.x), y2 = lo2f(yr.y), y3 = hi2f(yr.y);
      float sm = y0 + y1 + y2 + y3;
#pragma unroll
      for (int o = 8; o >= 1; o >>= 1) sm += __shfl_xor(sm, o, 64);
      const float mu = sm * (1.f / 64.f);
      const float d0 = y0 - mu, d1 = y1 - mu, d2 = y2 - mu, d3 = y3 - mu;
      float vs = d0 * d0 + d1 * d1 + d2 * d2 + d3 * d3;
#pragma unroll
      for (int o = 8; o >= 1; o >>= 1) vs += __shfl_xor(vs, o, 64);
      const float rs = rsqrtf(vs * (1.f / 64.f) + 1e-5f);
      uint2 o;
      o.x = pack2(d0 * rs * gw.x * siluf_(lo2f(gr.x)), d1 * rs * gw.y * siluf_(hi2f(gr.x)));
      o.y = pack2(d2 * rs * gw.z * siluf_(lo2f(gr.y)), d3 * rs * gw.w * siluf_(hi2f(gr.y)));
      *reinterpret_cast<uint2*>(Y + (size_t)row * 1024 + 768 + c) = o;
    }
    {
      const uint2 yr = *reinterpret_cast<const uint2*>(Y + (size_t)row * 1024 + 256 + c);
      const float y0 = lo2f(yr.x), y1 = hi2f(yr.x), y2 = lo2f(yr.y), y3 = hi2f(yr.y);
      float sm = y0 + y1 + y2 + y3;
#pragma unroll
      for (int o = 8; o >= 1; o >>= 1) sm += __shfl_xor(sm, o, 64);
      const float mu = sm * (1.f / 64.f);
      const float d0 = y0 - mu, d1 = y1 - mu, d2 = y2 - mu, d3 = y3 - mu;
      float vs = d0 * d0 + d1 * d1 + d2 * d2 + d3 * d3;
#pragma unroll
      for (int o = 8; o >= 1; o >>= 1) vs += __shfl_xor(vs, o, 64);
      const float rs = rsqrtf(vs * (1.f / 64.f) + 64e-5f);
      const float coef = RC[(size_t)row * 4 + (lane >> 4)];
      const uint2 vr = *reinterpret_cast<const uint2*>(RW + (size_t)row * 1536 + 1280 + c);
      const uint2 gr = *reinterpret_cast<const uint2*>(RG + (size_t)row * 256 + c);
      const float o0 = (d0 * rs * lw4.x + lb4.x + coef * lo2f(vr.x)) * lo2f(gr.x);
      const float o1 = (d1 * rs * lw4.y + lb4.y + coef * hi2f(vr.x)) * hi2f(gr.x);
      const float o2 = (d2 * rs * lw4.z + lb4.z + coef * lo2f(vr.y)) * lo2f(gr.y);
      const float o3 = (d3 * rs * lw4.w + lb4.w + coef * hi2f(vr.y)) * hi2f(gr.y);
      uint2 o;
      o.x = pack2(o0, o1);
      o.y = pack2(o2, o3);
      *reinterpret_cast<uint2*>(Y + (size_t)row * 1024 + 256 + c) = o;
    }
  }
}


#define XB_TMO      128
#define XB_XCNT(j)  (256  + 64 * (j))
#define XB_XSUB(j)  (1280 + 64 * (j))
#define XB_XGEN(j)  (2304 + 64 * (j))
#define XB_TOP      3328
#define XB_TOPGEN   3392
#define XCD_BAR_WORDS 3456
#define XB_SPIN_CAP (1u << 20)
#define LAS __attribute__((address_space(3)))
__device__ __forceinline__ unsigned xb_ld(unsigned* p) { return __hip_atomic_load(p, __ATOMIC_RELAXED, __HIP_MEMORY_SCOPE_AGENT); }
__device__ __forceinline__ unsigned xb_add(unsigned* p, unsigned v) { return __hip_atomic_fetch_add(p, v, __ATOMIC_RELAXED, __HIP_MEMORY_SCOPE_AGENT); }
__device__ __forceinline__ unsigned xb_xcc_id() { return (unsigned)__builtin_amdgcn_s_getreg((3 << 11) | 20) & 0xFu; }
#define XB_SPIN(cond, bar) do { unsigned _sp = 0; while (cond) { __builtin_amdgcn_s_sleep(1); \
    if ((++_sp & 255u) == 0u) { if (xb_ld(&(bar)[XB_TMO])) break; if (_sp > XB_SPIN_CAP) { atomicAdd(&(bar)[XB_TMO], 1u); break; } } } } while (0)
struct XcdBarrier { unsigned* bar; unsigned x; volatile LAS unsigned* st; };
__device__ __forceinline__ XcdBarrier xcd_barrier_post(unsigned* bar, volatile LAS unsigned* st) {
  XcdBarrier b; b.bar = bar; b.x = xb_xcc_id(); b.st = st;
  if (threadIdx.x == 0) (void)xb_add(&bar[XB_XCNT(b.x)], 1u);
  return b;
}
__device__ __forceinline__ void xcd_barrier_complete(unsigned* bar, unsigned x, unsigned& nloc, unsigned& nx) {
  const unsigned G = gridDim.x * gridDim.y * gridDim.z;
  unsigned sum, cnt, mine, sp = 0u;
  for (;;) {
    sum = 0u; cnt = 0u; mine = 0u;
#pragma unroll
    for (unsigned j = 0; j < 16; ++j) { const unsigned c = xb_ld(&bar[XB_XCNT(j)]); sum += c; cnt += (c > 0u) ? 1u : 0u; mine = (j == x) ? c : mine; }
    if (sum == G) break;
    __builtin_amdgcn_s_sleep(1);
    if ((++sp & 255u) == 0u) { if (xb_ld(&bar[XB_TMO])) break; if (sp > XB_SPIN_CAP) { atomicAdd(&bar[XB_TMO], 1u); break; } }
  }
  nloc = mine > 0u ? mine : 1u; nx = cnt > 0u ? cnt : 1u;
}
__device__ __forceinline__ void xcd_barrier(const XcdBarrier& b) {
  asm volatile("s_waitcnt vmcnt(0)" ::: "memory");
  __syncthreads();
  if (threadIdx.x == 0) {
    unsigned* bar = b.bar;
    __builtin_amdgcn_s_waitcnt(0);
    unsigned nloc = b.st[0], nx = b.st[1];
    if (nloc == 0u) { xcd_barrier_complete(bar, b.x, nloc, nx); b.st[0] = nloc; b.st[1] = nx; }
    const unsigned old = xb_add(&bar[XB_XSUB(b.x)], 1u);
    const unsigned gen = old / nloc;
    if (old + 1u == (gen + 1u) * nloc) {
      __builtin_amdgcn_fence(__ATOMIC_RELEASE, "agent");
      asm volatile("s_waitcnt vmcnt(0)" ::: "memory");
      const unsigned og = xb_add(&bar[XB_TOP], 1u);
      const unsigned tg = og / nx;
      if (og + 1u == (tg + 1u) * nx) xb_add(&bar[XB_TOPGEN], 1u);
      else XB_SPIN(xb_ld(&bar[XB_TOPGEN]) == tg, bar);
      __builtin_amdgcn_fence(__ATOMIC_ACQUIRE, "agent");
      xb_add(&bar[XB_XGEN(b.x)], 1u);
      asm volatile("s_waitcnt vmcnt(0)" ::: "memory");
    } else {
      XB_SPIN(xb_ld(&bar[XB_XGEN(b.x)]) == gen, bar);
      __builtin_amdgcn_fence(__ATOMIC_ACQUIRE, "agent");
      asm volatile("s_waitcnt vmcnt(0)" ::: "memory");
    }
  }
  __syncthreads();
}

constexpr int NPH = NL * 9 + 1;
#ifndef SCAN_REP
#define SCAN_REP 0
#endif
#ifndef PH_MASK
#define PH_MASK 0x3ff
#endif

__device__ __forceinline__ void run_phase(CP p, int ph, char* smem_full) {
  const int l = ph / 9, s = ph % 9;
  const int vb = bidx(), NVB = nvb();
  char* smem = smem_full + half_id() * 65536;
  bf16_t* WA = (bf16_t*)(p.ws + WS_WA);
  bf16_t* WB = (bf16_t*)(p.ws + WS_WB);
  bf16_t* WO = (bf16_t*)(p.ws + WS_WO);
  bf16_t* PROJ = (bf16_t*)(p.ws + WS_PROJ);
  bf16_t* Yb = (bf16_t*)(p.ws + WS_Y);
  float* TMP = (float*)(p.ws + WS_TMP);
  if (ph == NPH - 1) {
    rowwise_phase(p, 1, p.in[5] + (NL - 1) * D, nullptr, false, DFF / 256);
    return;
  }
  if (!((PH_MASK >> s) & 1)) return;
  switch (s) {
    case 0: {
      if (l == 0) {
        float2* rope = (float2*)(p.ws + WS_ROPE);
        for (int i = vb * 256 + tidx(); i < T * 16; i += NVB * 256) {
          const int t = i >> 4, f = i & 15;
          const float freq = powf(10000.f, -(float)f / 16.f);
          const float ang = (float)t * freq;
          rope[i] = make_float2(cosf(ang), sinf(ang));
        }
        rowwise_phase(p, 0, nullptr, p.in[2], true, 0);
      } else {
        rowwise_phase(p, 1, p.in[5] + (l - 1) * D, p.in[2] + l * D, true, DFF / 256);
      }
      conv_matrix(p.in[6] + (size_t)l * D * MIXIN, WA, D, MIXIN, NIN_PAD, 0, smem, vb, NVB);
      for (int id = NVB - 1 - vb; id < 24; id += NVB) {
        if (id < 4) conv_tile(p.in[16] + (size_t)l * 64 * 256, (bf16_t*)(p.ws + WS_W2T), 64, 256, 0, id * 64, 0, smem);
        else if (id < 8) conv_tile(p.in[18] + (size_t)l * 64 * 256, (bf16_t*)(p.ws + WS_A2T), 64, 256, 0, (id - 4) * 64, 0, smem);
        else if (id < 16) conv_tile(p.in[19] + (size_t)l * 128 * 256, (bf16_t*)(p.ws + WS_G2T), 128, 256, ((id - 8) & 1) * 64, ((id - 8) >> 1) * 64, 0, smem);
        else if (id < 20) conv_tile(p.in[27] + (size_t)l * 16384 + (size_t)(id - 16) * 4096, (bf16_t*)(p.ws + WS_WAT) + (id - 16) * 4096, 64, 64, 0, 0, 0, smem);
        else conv_tile(p.in[29] + (size_t)l * 16384 + (size_t)(id - 20) * 4096, (bf16_t*)(p.ws + WS_WXT) + (id - 20) * 4096, 64, 64, 0, 0, 0, smem);
      }
    } break;
    case 1: gemm_phase256<EPI_BF16>(Yb, WA, D, 14, smem_full, PROJ, PJ, MIXIN); break;
    case 2: {
      for (int u = vb; u < NB * 129; u += NVB) prep_unit(p, l, u, smem);
    } break;
    case 3: {
      for (int u = vb; u < 320; u += NVB) {
        if (u < 128) { for (int rr_ = 0; rr_ < ((SCAN_REP >> 0) & 1) + 1; ++rr_) rwkv_scan_unit(p, u, smem); }
        else if (u < 256) { for (int rr_ = 0; rr_ < ((SCAN_REP >> 1) & 1) + 1; ++rr_) ssd_scan_unit(p, l, u - 128, smem); }
        else if (u < 272) ret_mfma_unit(p, l, u - 256, smem);
        else if (u < 288) { }
        else if (u < 320) { for (int rr_ = 0; rr_ < ((SCAN_REP >> 3) & 1) + 1; ++rr_) lru_scan_unit(p, u - 288, smem); }
      }
      {
        const int nwork = NVB > 320 ? NVB - 320 : NVB;
        const int wk = NVB > 320 ? vb - 320 : vb;
        const int ngu = 16 * 44;
        if (wk >= 0) {
          for (int id = wk; id < 256 + 2 * ngu + 44 * 16; id += nwork) {
            if (id < 256) conv_tile(p.in[7] + (size_t)l * D * D, WO, D, D, (id % 16) * 64, (id / 16) * 64, 0, smem);
            else if (id < 256 + ngu) { const int k = id - 256; conv_tile(p.in[33] + (size_t)l * D * DFF, WA, D, DFF, (k % 16) * 64, (k / 16) * 64, 1, smem); }
            else if (id < 256 + 2 * ngu) { const int k = id - 256 - ngu; conv_tile(p.in[34] + (size_t)l * D * DFF, WA, D, DFF, (k % 16) * 64, (k / 16) * 64, 2, smem); }
            else { const int k = id - 256 - 2 * ngu; conv_tile(p.in[35] + (size_t)l * DFF * D, WB, DFF, D, (k % 44) * 64, (k / 44) * 64, 0, smem); }
          }
        }
      }
    } break;
    case 4: epi_phase(p, l); break;
    case 5: gemm_phase_n1024<D>(p, Yb, WO, smem_full, TMP); break;
    case 8: gemm_phase_n1024<DFF>(p, PROJ, WB, smem_full, TMP); break;
    case 6: rowwise_phase(p, 1, p.in[3] + l * D, p.in[4] + l * D, true, D / 256); break;
    case 7: gemm_phase256<EPI_GLU>(Yb, WA, D, 22, smem_full, PROJ, DFF, DFF); break;
  }
}

#ifndef SCAN_REP
#define SCAN_REP 0
#endif
#ifndef REPEAT_MASK
#define REPEAT_MASK 0
#endif
__global__ void __launch_bounds__(512) hybrid_trunk_kernel(Params p, int ph_lo, int ph_hi) {
  __shared__ __attribute__((aligned(16))) char smem[131072 + 16];
  cg::grid_group grid = cg::this_grid();
#if MULTI_LAUNCH
  for (int ph = ph_lo; ph < ph_hi; ++ph) {
    run_phase(*(const __attribute__((address_space(4))) Params*)__builtin_amdgcn_kernarg_segment_ptr(), ph, smem);
    if (ph + 1 < ph_hi) grid.sync();
  }
#else
  volatile LAS unsigned* stw = (volatile LAS unsigned*)(smem + 131072);
  if (threadIdx.x < 4) stw[threadIdx.x] = 0u;
  __syncthreads();
  XcdBarrier xb = xcd_barrier_post((unsigned*)(p.ws + WS_BAR), stw);
  if (ph_hi < 0) grid.sync();
  for (int ph = ph_lo; ph < ph_hi; ++ph) {
    const int nrep = (REPEAT_MASK != 0 && ph < NPH - 1 && ((REPEAT_MASK >> (ph % 9)) & 1)) ? 2 : 1;
    for (int r = 0; r < nrep; ++r) {
      {
        const __attribute__((address_space(4))) Params* pp = (const __attribute__((address_space(4))) Params*)__builtin_amdgcn_kernarg_segment_ptr();
        asm volatile("" : "+s"(pp));
        run_phase(*pp, ph, smem);
      }
      if (r + 1 < nrep || ph + 1 < ph_hi) xcd_barrier(xb);
    }
  }
#endif
}

extern "C" void kernel_launch(void* const* d_in, const int* in_sizes, int n_in, void* d_out, int out_size, void* d_ws,
                              size_t ws_size, hipStream_t stream) {
  static int grid_blocks = 0;
  if (!grid_blocks) {
    int dev = 0, cus = 0, per_cu = 0;
    hipGetDevice(&dev);
    hipDeviceGetAttribute(&cus, hipDeviceAttributeMultiprocessorCount, dev);
    hipOccupancyMaxActiveBlocksPerMultiprocessor(&per_cu, hybrid_trunk_kernel, 512, 0);
    if (per_cu > 1) per_cu = 1;
    if (per_cu < 1) per_cu = 1;
    grid_blocks = cus * per_cu;
  }
  if (ws_size < WS_TOTAL || n_in < 36) {
    fprintf(stderr, "workspace too small: %zu < %zu\n", ws_size, (size_t)WS_END);
    return;
  }
  Params p{};
  for (int i = 0; i < 36; ++i) p.in[i] = (const float*)d_in[i];
  p.out = (float*)d_out;
  p.ws = (char*)d_ws;
#if MULTI_LAUNCH
  for (int ph = 0; ph < NPH; ++ph) {
    hipLaunchKernelGGL(hybrid_trunk_kernel, dim3(grid_blocks), dim3(512), 0, stream, p, ph, ph + 1);
  }
#else
  hipMemsetAsync((char*)d_ws + WS_BAR, 0, XCD_BAR_WORDS * 4, stream);
  int lo = 0, hi = NPH;
  void* args[] = {&p, &lo, &hi};
  hipError_t e = hipLaunchCooperativeKernel((void*)hybrid_trunk_kernel, dim3(grid_blocks), dim3(512), args, 0, stream);
  if (e != hipSuccess) fprintf(stderr, "cooperative launch failed: %s (grid %d)\n", hipGetErrorString(e), grid_blocks);
#endif
}
```

```cpp
#include <hip/hip_runtime.h>
#include <hip/hip_bf16.h>
#include <hip/hip_cooperative_groups.h>
#include <cstdio>
#include <cstdint>
namespace cg = cooperative_groups;

#ifndef MULTI_LAUNCH
#define MULTI_LAUNCH 0
#endif

typedef unsigned short bf16_t;
using bf16x8 = __attribute__((ext_vector_type(8))) short;
using f32x4 = __attribute__((ext_vector_type(4))) float;

constexpr int D = 1024, NB = 8, SEQ = 2048, NMETA = 16, T = 2064, R = NB * T, NL = 4;
constexpr int RREAL = NB * SEQ;
constexpr int MIXIN = 3332, PJ = 3336, NIN_PAD = 3456, DFF = 2816;
constexpr int OFF_Z = 0, OFF_XBC = 256, OFF_DT = 1024, OFF_RW = 1028, OFF_LRU = 2052, OFF_RET = 2564;
constexpr float EPS = 1e-6f;

constexpr size_t WS_BAR = 0;
constexpr size_t WS_HMETA = 16384;
constexpr size_t WS_ROPE = WS_HMETA + 128 * 1024 * 4;
constexpr size_t WS_WA = 1048576;
constexpr size_t WS_WB = WS_WA + (size_t)5632 * 1024 * 2;
constexpr size_t WS_PROJ = WS_WB + (size_t)1024 * 2816 * 2;
constexpr size_t WS_Y = WS_PROJ + (size_t)R * PJ * 2;
constexpr size_t WS_SCR = WS_Y + (size_t)R * 1024 * 2;
constexpr size_t WS_RW = WS_SCR;
constexpr size_t WS_SS = WS_RW + (size_t)R * 1536 * 2;
constexpr size_t WS_LR = WS_SS + (size_t)R * 768 * 2;
constexpr size_t WS_RG = WS_LR + (size_t)R * 512 * 2;
constexpr size_t WS_RC = WS_RG + (size_t)R * 256 * 2;
constexpr size_t WS_SD = WS_RC + (size_t)R * 4 * 4;
constexpr size_t WS_END = WS_SD + (size_t)R * 4 * 4;
constexpr size_t WS_WO = WS_END;
constexpr size_t WS_TOTAL = WS_WO + (size_t)1024 * 1024 * 2;
constexpr size_t WS_TMP = WS_SCR;
static_assert((size_t)R * 1024 * 4 <= WS_END - WS_SCR, "tmp must fit in scratch");

struct Params {
  const float* in[36];
  float* out;
  char* ws;
};
typedef const __attribute__((address_space(4))) Params& CP;

__device__ __forceinline__ float bf2f(bf16_t v) { return __uint_as_float(((unsigned)v) << 16); }
typedef __bf16 hwbf16x2 __attribute__((ext_vector_type(2)));
typedef float hwf32x2 __attribute__((ext_vector_type(2)));
__device__ __forceinline__ unsigned pack2(float a, float b) {
  const hwf32x2 v = {a, b};
  const hwbf16x2 r = __builtin_convertvector(v, hwbf16x2);
  return __builtin_bit_cast(unsigned, r);
}
__device__ __forceinline__ bf16_t f2bf(float f) { return (bf16_t)(pack2(f, 0.f) & 0xffffu); }
__device__ __forceinline__ float lo2f(unsigned w) { return __uint_as_float(w << 16); }
__device__ __forceinline__ float hi2f(unsigned w) { return __uint_as_float(w & 0xffff0000u); }
__device__ __forceinline__ float sigmoidf_(float x) { return __builtin_amdgcn_rcpf(1.f + __expf(-x)); }
__device__ __forceinline__ float softplusf_(float x) { return fmaxf(x, 0.f) + log1pf(__expf(-fabsf(x))); }
__device__ __forceinline__ float siluf_(float x) { return x * __builtin_amdgcn_rcpf(1.f + __expf(-x)); }
__device__ __forceinline__ float wave_sum(float v) {
#pragma unroll
  for (int o = 32; o >= 1; o >>= 1) v += __shfl_xor(v, o, 64);
  return v;
}
__device__ __forceinline__ int tidx() { int t = threadIdx.x & 255; asm volatile("" : "+v"(t)); return t; }
__device__ __forceinline__ int tidx_full() { int t = threadIdx.x; asm volatile("" : "+v"(t)); return t; }
__device__ __forceinline__ int half_id() { int t = (int)(threadIdx.x >> 8); asm volatile("" : "+v"(t)); return __builtin_amdgcn_readfirstlane(t); }
__device__ __forceinline__ int bidx() { int t = blockIdx.x + half_id() * gridDim.x; asm volatile("" : "+s"(t)); return t; }
__device__ __forceinline__ int nvb() { return gridDim.x * 2; }
#define LAS3 __attribute__((address_space(3)))
__device__ __forceinline__ void half_barrier(char* smem_half) {
  const int h = half_id();
  LAS3 unsigned* cnt = (LAS3 unsigned*)(smem_half + (2 - h) * 65536 + 8 + h * 4);
  asm volatile("s_waitcnt lgkmcnt(0)" ::: "memory");
  if ((tidx() & 63) == 0) {
    const unsigned old = __hip_atomic_fetch_add(cnt, 1u, __ATOMIC_RELAXED, __HIP_MEMORY_SCOPE_WORKGROUP);
    const unsigned target = (old & ~3u) + 4u;
    while (__hip_atomic_load(cnt, __ATOMIC_RELAXED, __HIP_MEMORY_SCOPE_WORKGROUP) < target) __builtin_amdgcn_s_sleep(1);
  }
  asm volatile("" ::: "memory");
}
template <int CTRL>
__device__ __forceinline__ float dppf(float x) {
  return __int_as_float(__builtin_amdgcn_update_dpp(0, __float_as_int(x), CTRL, 0xF, 0xF, true));
}
__device__ __forceinline__ float allreduce4(float x) {
  x += dppf<0xB1>(x);
  x += dppf<0x4E>(x);
  return x;
}
__device__ __forceinline__ float allreduce16(float x) {
  x += dppf<0xB1>(x);
  x += dppf<0x4E>(x);
  x += dppf<0x141>(x);
  x += dppf<0x140>(x);
  return x;
}
__device__ __forceinline__ int rowof(int b, int t) { return t < NMETA ? RREAL + b * NMETA + t : b * SEQ + t - NMETA; }
__device__ __forceinline__ float* hrow_ptr(CP p, int row) {
  return row < RREAL ? p.out + (size_t)row * D : (float*)(p.ws + WS_HMETA) + (size_t)(row - RREAL) * D;
}

__device__ __forceinline__ int lds_byte(int r, int c) {
  int st = (r >> 4) * 2 + (c >> 5), rr = r & 15, cc = c & 31, ob = rr * 64 + cc * 2;
  return st * 1024 + (ob ^ (((ob >> 9) & 1) << 5));
}
__device__ __forceinline__ void stage_rc(int b, int& Rr, int& Cc) {
  int st = b / 1024, sb = b % 1024, swz = sb ^ (((sb >> 9) & 1) << 5);
  Rr = (st >> 1) * 16 + swz / 64;
  Cc = (st & 1) * 32 + (swz % 64) / 2;
}
typedef __attribute__((address_space(3))) unsigned lds_u32;
typedef __attribute__((address_space(1))) const unsigned glb_u32;

enum { EPI_BF16 = 0, EPI_F32 = 1, EPI_GLU = 2, EPI_PART = 3 };

template <int EPI>
__device__ __forceinline__ void gemm_tile256(const bf16_t* __restrict__ A, const bf16_t* __restrict__ Bt, int K, int nk, int brow, int bcol,
                             char* smem, void* outp, int ldo, int nvalid) {
  const int tid = tidx_full(), wid = tid >> 6, lane = tid & 63, wr = wid >> 2, wc = wid & 3, fr = lane & 15, fq = lane >> 4;
  f32x4 acc[8][4];
#pragma unroll
  for (int m = 0; m < 8; ++m)
#pragma unroll
    for (int n = 0; n < 4; ++n) acc[m][n] = f32x4{0.f, 0.f, 0.f, 0.f};
  const bf16_t* Ab = A + (size_t)brow * K;
  const bf16_t* Bb = Bt + (size_t)bcol * K;
  int soff[4];
#pragma unroll
  for (int i = 0; i < 4; ++i) {
    int r, c;
    stage_rc(tid * 16 + i * 8192, r, c);
    soff[i] = r * K + c;
  }
  auto stage = [&](int buf, int kt) {
    char* sa = smem + buf * 65536;
    char* sb = sa + 32768;
#pragma unroll
    for (int i = 0; i < 4; ++i) {
      const int b = tid * 16 + i * 8192;
      __builtin_amdgcn_global_load_lds((glb_u32*)(Ab + soff[i] + kt * 64), (lds_u32*)(sa + b), 16, 0, 0);
      __builtin_amdgcn_global_load_lds((glb_u32*)(Bb + soff[i] + kt * 64), (lds_u32*)(sb + b), 16, 0, 0);
    }
  };
  stage(0, 0);
  for (int kt = 0; kt < nk; ++kt) {
    asm volatile("s_waitcnt vmcnt(0)" ::: "memory");
    __syncthreads();
    if (kt + 1 < nk) stage((kt + 1) & 1, kt + 1);
    const char* sa = smem + (kt & 1) * 65536;
    const char* sb = sa + 32768;
#pragma unroll
    for (int k = 0; k < 2; ++k) {
      bf16x8 af[8], bfr[4];
#pragma unroll
      for (int m = 0; m < 8; ++m) af[m] = *reinterpret_cast<const bf16x8*>(sa + lds_byte(wr * 128 + m * 16 + fr, k * 32 + fq * 8));
#pragma unroll
      for (int n = 0; n < 4; ++n) bfr[n] = *reinterpret_cast<const bf16x8*>(sb + lds_byte(wc * 64 + n * 16 + fr, k * 32 + fq * 8));
      __builtin_amdgcn_sched_barrier(0);
#pragma unroll
      for (int m = 0; m < 8; ++m)
#pragma unroll
        for (int n = 0; n < 4; ++n) acc[m][n] = __builtin_amdgcn_mfma_f32_16x16x32_bf16(bfr[n], af[m], acc[m][n], 0, 0, 0);
      __builtin_amdgcn_sched_barrier(0);
    }
  }
  __syncthreads();
  if (EPI == EPI_BF16) {
    bf16_t* O = (bf16_t*)outp;
#pragma unroll
    for (int m = 0; m < 8; ++m) {
      const int row = brow + wr * 128 + m * 16 + fr;
#pragma unroll
      for (int n = 0; n < 4; ++n) {
        const int col = bcol + wc * 64 + n * 16 + fq * 4;
        if (col < nvalid && row < R)
          *reinterpret_cast<uint2*>(O + (size_t)row * ldo + col) = make_uint2(pack2(acc[m][n][0], acc[m][n][1]), pack2(acc[m][n][2], acc[m][n][3]));
      }
    }
  } else if (EPI == EPI_F32) {
    float* O = (float*)outp;
#pragma unroll
    for (int m = 0; m < 8; ++m) {
      const int row = brow + wr * 128 + m * 16 + fr;
#pragma unroll
      for (int n = 0; n < 4; ++n) {
        const int col = bcol + wc * 64 + n * 16 + fq * 4;
        if (row < R) *reinterpret_cast<float4*>(O + (size_t)row * ldo + col) = make_float4(acc[m][n][0], acc[m][n][1], acc[m][n][2], acc[m][n][3]);
      }
    }
  } else if (EPI == EPI_PART) {
    float* O = (float*)outp;
    if (wr == 0) {
#pragma unroll
      for (int m = 0; m < 8; ++m)
#pragma unroll
        for (int n = 0; n < 4; ++n) {
          const int col = bcol + wc * 64 + n * 16 + fq * 4;
          *reinterpret_cast<float4*>(O + (size_t)(m * 16 + fr) * ldo + col) = make_float4(acc[m][n][0], acc[m][n][1], acc[m][n][2], acc[m][n][3]);
        }
    }
  } else {
    bf16_t* O = (bf16_t*)outp;
#pragma unroll
    for (int m = 0; m < 8; ++m) {
      const int row = brow + wr * 128 + m * 16 + fr;
#pragma unroll
      for (int n = 0; n < 2; ++n) {
        const int col = (bcol >> 8) * 128 + wc * 32 + n * 16 + fq * 4;
        float a[4];
#pragma unroll
        for (int j = 0; j < 4; ++j) a[j] = siluf_(acc[m][n][j]) * acc[m][n + 2][j];
        if (row < R) *reinterpret_cast<uint2*>(O + (size_t)row * ldo + col) = make_uint2(pack2(a[0], a[1]), pack2(a[2], a[3]));
      }
    }
  }
}

template <int EPI>
__device__ __forceinline__ void gemm_tile8p(const bf16_t* __restrict__ Ag, const bf16_t* __restrict__ Bg, int K, int nt, int brow, int bcol,
                                            char* smem, void* outp, int ldo, int nvalid, int rowoff, int rowlim) {
  constexpr int HT = 128 * 64, HALF = 128;
  bf16_t* shm = (bf16_t*)smem;
  const int tid = tidx_full();
  const int wid = tid >> 6, lane = tid & 63, wr = wid >> 2, wc = wid & 3, fr = lane & 15, fq = lane >> 4;
  int goff0;
  { int r, c; stage_rc(tid * 16, r, c); goff0 = r * K + c; }
#define SA8(b, h) (shm + ((b) * 2 + (h)) * HT)
#define SB8(b, h) (shm + (4 + (b) * 2 + (h)) * HT)
#define STAGE8(P, BASE, br, kt) do { const bf16_t* _g = (BASE) + (size_t)(br) * K + (kt) * 64; \
    _Pragma("unroll") for (int _i = 0; _i < 2; ++_i) \
      __builtin_amdgcn_global_load_lds((glb_u32*)(_g + goff0 + _i * 64 * K), (lds_u32*)((char*)(P) + tid * 16 + _i * 8192), 16, 0, 0); } while (0)
#define LDA8(dst, b, h) _Pragma("unroll") for (int m = 0; m < 4; ++m) _Pragma("unroll") for (int k = 0; k < 2; ++k) \
    dst[m][k] = *reinterpret_cast<const bf16x8*>((const char*)SA8(b, h) + lds_byte(wr * 64 + m * 16 + fr, k * 32 + fq * 8))
#define LDB8(dst, b, h) _Pragma("unroll") for (int n = 0; n < 2; ++n) _Pragma("unroll") for (int k = 0; k < 2; ++k) \
    dst[n][k] = *reinterpret_cast<const bf16x8*>((const char*)SB8(b, h) + lds_byte(wc * 32 + n * 16 + fr, k * 32 + fq * 8))
#define MMA8(ai, bj, Af, Bf) do { __builtin_amdgcn_s_setprio(3); \
    _Pragma("unroll") for (int m = 0; m < 4; ++m) _Pragma("unroll") for (int n = 0; n < 2; ++n) _Pragma("unroll") for (int k = 0; k < 2; ++k) \
      acc[ai][bj][m][n] = __builtin_amdgcn_mfma_f32_16x16x32_bf16(Af[m][k], Bf[n][k], acc[ai][bj][m][n], 0, 0, 0); \
    __builtin_amdgcn_s_setprio(0); } while (0)
#define WAIT_V8(n) asm volatile("s_waitcnt vmcnt(" #n ")" ::: "memory")
#define WAIT_L8(n) asm volatile("s_waitcnt lgkmcnt(" #n ")" ::: "memory")
#define BAR8 __builtin_amdgcn_s_barrier()
#define SCHED8 __builtin_amdgcn_sched_barrier(0)
  f32x4 acc[2][2][4][2];
#pragma unroll
  for (int a = 0; a < 2; ++a)
#pragma unroll
    for (int b = 0; b < 2; ++b)
#pragma unroll
      for (int m = 0; m < 4; ++m)
#pragma unroll
        for (int n = 0; n < 2; ++n) acc[a][b][m][n] = f32x4{0.f, 0.f, 0.f, 0.f};
  bf16x8 At[4][2], B0[2][2], B1[2][2];
  STAGE8(SB8(0, 0), Bg, bcol, 0); STAGE8(SA8(0, 0), Ag, brow, 0);
  STAGE8(SB8(0, 1), Bg, bcol + HALF, 0); STAGE8(SA8(0, 1), Ag, brow + HALF, 0);
  if (wr == 1) BAR8;
  WAIT_V8(4); BAR8;
  STAGE8(SB8(1, 0), Bg, bcol, 1); STAGE8(SA8(1, 0), Ag, brow, 1); STAGE8(SB8(1, 1), Bg, bcol + HALF, 1);
  WAIT_V8(6); BAR8;
  for (int t = 0; t < nt - 2; t += 2) {
    LDB8(B0, 0, 0); SCHED8; LDA8(At, 0, 0); STAGE8(SA8(1, 1), Ag, brow + HALF, t + 1);
    WAIT_L8(8); BAR8; WAIT_L8(0); MMA8(0, 0, At, B0); BAR8; SCHED8;
    LDB8(B1, 0, 1); STAGE8(SB8(0, 0), Bg, bcol, t + 2);
    BAR8; WAIT_L8(0); MMA8(0, 1, At, B1); BAR8;
    LDA8(At, 0, 1); STAGE8(SA8(0, 0), Ag, brow, t + 2);
    BAR8; WAIT_L8(0); MMA8(1, 0, At, B0); BAR8; SCHED8;
    STAGE8(SB8(0, 1), Bg, bcol + HALF, t + 2);
    WAIT_V8(6); BAR8; MMA8(1, 1, At, B1); BAR8;
    LDB8(B0, 1, 0); SCHED8; LDA8(At, 1, 0); STAGE8(SA8(0, 1), Ag, brow + HALF, t + 2);
    WAIT_L8(8); BAR8; WAIT_L8(0); MMA8(0, 0, At, B0); BAR8; SCHED8;
    LDB8(B1, 1, 1); STAGE8(SB8(1, 0), Bg, bcol, t + 3);
    BAR8; WAIT_L8(0); MMA8(0, 1, At, B1); BAR8;
    LDA8(At, 1, 1); STAGE8(SA8(1, 0), Ag, brow, t + 3);
    BAR8; WAIT_L8(0); MMA8(1, 0, At, B0); BAR8; SCHED8;
    STAGE8(SB8(1, 1), Bg, bcol + HALF, t + 3);
    WAIT_V8(6); BAR8; MMA8(1, 1, At, B1); BAR8;
  }
  { LDB8(B0, 0, 0); LDA8(At, 0, 0); STAGE8(SA8(1, 1), Ag, brow + HALF, nt - 1);
    BAR8; WAIT_L8(0); MMA8(0, 0, At, B0); BAR8;
    LDB8(B1, 0, 1); BAR8; WAIT_L8(0); MMA8(0, 1, At, B1); BAR8;
    LDA8(At, 0, 1); WAIT_V8(4); BAR8; WAIT_L8(0); MMA8(1, 0, At, B0); MMA8(1, 1, At, B1); BAR8; }
  { LDB8(B0, 1, 0); LDA8(At, 1, 0); WAIT_V8(2); BAR8; WAIT_L8(0); MMA8(0, 0, At, B0); BAR8;
    LDB8(B1, 1, 1); WAIT_V8(0); BAR8; WAIT_L8(0); MMA8(0, 1, At, B1); BAR8;
    LDA8(At, 1, 1); BAR8; WAIT_L8(0); MMA8(1, 0, At, B0); MMA8(1, 1, At, B1); BAR8; }
  if (wr == 0) BAR8;
#pragma unroll
  for (int ai = 0; ai < 2; ++ai)
#pragma unroll
    for (int m = 0; m < 4; ++m)
#pragma unroll
      for (int j = 0; j < 4; ++j) {
        const int rl = ai * HALF + wr * 64 + m * 16 + fq * 4 + j;
        const size_t orow = (size_t)(rowoff + rl) * ldo;
        if (EPI == EPI_GLU) {
#pragma unroll
          for (int n = 0; n < 2; ++n) {
            const int col = (bcol >> 8) * 128 + wc * 32 + n * 16 + fr;
            const float g = acc[ai][0][m][n][j], u = acc[ai][1][m][n][j];
            if (rl < rowlim) ((bf16_t*)outp)[orow + col] = f2bf(siluf_(g) * u);
          }
        } else {
#pragma unroll
          for (int bj = 0; bj < 2; ++bj)
#pragma unroll
            for (int n = 0; n < 2; ++n) {
              const int col = bcol + bj * HALF + wc * 32 + n * 16 + fr;
              const float v = acc[ai][bj][m][n][j];
              if (EPI == EPI_BF16) { if (rl < rowlim && col < nvalid) ((bf16_t*)outp)[orow + col] = f2bf(v); }
              else { if (rl < rowlim) ((float*)outp)[orow + col] = v; }
            }
        }
        __builtin_amdgcn_sched_barrier(0);
      }
#undef SA8
#undef SB8
#undef STAGE8
#undef LDA8
#undef LDB8
#undef MMA8
#undef WAIT_V8
#undef WAIT_L8
#undef BAR8
#undef SCHED8
  __syncthreads();
}

template <int EPI>
__device__ __forceinline__ void gemm_phase256(const bf16_t* A, const bf16_t* Bt, int K, int NT, char* smem, void* outp, int ldo, int nvalid) {
  constexpr int TM = (R + 255) / 256;
  const int ntiles = TM * NT;
  const int nb = gridDim.x;
  const int xcd = blockIdx.x & 7, slot = blockIdx.x >> 3, per = nb >> 3;
  for (int it = 0; it * nb < ntiles; ++it) {
    const int k = (it * 8 + xcd) * per + slot;
    if (k >= ntiles) continue;
    const int panel = k / (TM * 8);
    const int w = min(8, NT - panel * 8);
    const int idx = k - panel * TM * 8;
    const int tm = idx / w, tn = panel * 8 + idx % w;
    gemm_tile8p<EPI>(A, Bt, K, K >> 6, tm * 256, tn * 256, smem, outp, ldo, nvalid, tm * 256, R - tm * 256);
  }
}

constexpr size_t WS_PART = WS_TMP + (size_t)68 * 1024 * 1024;
static_assert(WS_PART + (size_t)11 * 128 * 1024 * 4 <= WS_END, "partial slabs must fit");
template <int K>
__device__ __forceinline__ void gemm_phase_n1024(CP p, const bf16_t* A, const bf16_t* Bt, char* smem, float* outp) {
  const int nb = gridDim.x;
  const int xcd = blockIdx.x & 7, slot = blockIdx.x >> 3, per = nb >> 3;
  const int nkc = K >> 8;
  const int nmain = 256, nitems = nmain + 4 * nkc;
  float* part = (float*)(p.ws + WS_PART);
  for (int it = 0; it * nb < nitems; ++it) {
    int id = it * nb + blockIdx.x;
    if ((it + 1) * nb <= nmain) id = (it * 8 + xcd) * per + slot;
    if (id >= nitems) break;
    const bf16_t* Ai = A; const bf16_t* Bi = Bt; float* Oi = outp;
    int nti = K >> 6, brow = (id >> 2) * 256, bcol = (id & 3) * 256, rowoff = brow, rowlim = 256;
    if (id >= nmain) {
      const int pid = id - nmain, kc = pid >> 2;
      Ai = A + kc * 256; Bi = Bt + kc * 256; Oi = part + (size_t)kc * 128 * 1024;
      nti = 4; brow = RREAL; bcol = (pid & 3) * 256; rowoff = 0; rowlim = 128;
    }
    gemm_tile8p<EPI_F32>(Ai, Bi, K, nti, brow, bcol, smem, Oi, D, D, rowoff, rowlim);
  }
}

__device__ __forceinline__ int map_n(int n, int maptype) {
  if (maptype == 0) return n;
  return (n >> 7) * 256 + (n & 127) + (maptype == 2 ? 128 : 0);
}
__device__ __forceinline__ void conv_tile(const float* __restrict__ src, bf16_t* __restrict__ dst, int K, int N, int k0, int n0, int maptype,
                          char* smem) {
  bf16_t* tile = (bf16_t*)smem;
  const int tid = tidx();
  half_barrier(smem);
#pragma unroll
  for (int i = 0; i < 4; ++i) {
    const int idx = tid + i * 256, k = idx >> 4, c4 = idx & 15, n = n0 + c4 * 4;
    float4 v = make_float4(0.f, 0.f, 0.f, 0.f);
    if (n < N) v = *reinterpret_cast<const float4*>(src + (size_t)(k0 + k) * N + n);
    tile[(c4 * 4 + 0) * 72 + k] = f2bf(v.x);
    tile[(c4 * 4 + 1) * 72 + k] = f2bf(v.y);
    tile[(c4 * 4 + 2) * 72 + k] = f2bf(v.z);
    tile[(c4 * 4 + 3) * 72 + k] = f2bf(v.w);
  }
  half_barrier(smem);
#pragma unroll
  for (int i = 0; i < 2; ++i) {
    const int idx = tid + i * 256, n = idx >> 3, kc = idx & 7;
    uint4 v = *reinterpret_cast<const uint4*>(tile + n * 72 + kc * 8);
    *reinterpret_cast<uint4*>(dst + (size_t)map_n(n0 + n, maptype) * K + k0 + kc * 8) = v;
  }
}
__device__ __forceinline__ void conv_matrix(const float* src, bf16_t* dst, int K, int N, int Npad, int maptype, char* smem, int start, int stride) {
  const int nkt = K / 64, nnt = Npad / 64;
  for (int id = start; id < nkt * nnt; id += stride) conv_tile(src, dst, K, N, (id % nkt) * 64, (id / nkt) * 64, maptype, smem);
}

__device__ __forceinline__ void rowwise_phase(CP p, int mode, const float* wpost, const float* wpre, bool write_hn, int nparts) {
  const int tid_ = tidx(); const int lane = tid_ & 63, gw = bidx() * 4 + (tid_ >> 6), nw = nvb() * 4;
  const float* tmp = (const float*)(p.ws + WS_TMP);
  bf16_t* hn = (bf16_t*)(p.ws + WS_Y);
  float4 wpo[4], wpr[4];
#pragma unroll
  for (int q = 0; q < 4; ++q) {
    wpo[q] = (mode != 0) ? *reinterpret_cast<const float4*>(wpost + q * 256 + lane * 4) : make_float4(0.f, 0.f, 0.f, 0.f);
    wpr[q] = write_hn ? *reinterpret_cast<const float4*>(wpre + q * 256 + lane * 4) : make_float4(0.f, 0.f, 0.f, 0.f);
  }
  float4 tv[4], hv[4], tvn[4], hvn[4], tvm[4], hvm[4];
  auto loadrow = [&](int row, float4 (&t)[4], float4 (&h)[4]) {
    if (mode == 0) {
      const float* src = row < RREAL ? p.in[0] + (size_t)row * D : p.in[1] + (size_t)((row - RREAL) & 15) * D;
#pragma unroll
      for (int q = 0; q < 4; ++q) { h[q] = *reinterpret_cast<const float4*>(src + q * 256 + lane * 4); t[q] = make_float4(0.f, 0.f, 0.f, 0.f); }
    } else {
      const float* hr = hrow_ptr(p, row);
#pragma unroll
      for (int q = 0; q < 4; ++q) {
        if (row < RREAL) {
          {
            const float* tp_ = tmp + (size_t)row * D + q * 256 + lane * 4;
            t[q] = make_float4(__builtin_nontemporal_load(tp_), __builtin_nontemporal_load(tp_ + 1), __builtin_nontemporal_load(tp_ + 2), __builtin_nontemporal_load(tp_ + 3));
          }
        } else {
          const float* pp = (const float*)(p.ws + WS_PART) + (size_t)(row - RREAL) * D + q * 256 + lane * 4;
          float4 a = *reinterpret_cast<const float4*>(pp);
          for (int kc = 1; kc < nparts; ++kc) {
            const float4 c = *reinterpret_cast<const float4*>(pp + (size_t)kc * 128 * 1024);
            a.x += c.x; a.y += c.y; a.z += c.z; a.w += c.w;
          }
          t[q] = a;
        }
        h[q] = *reinterpret_cast<const float4*>(hr + q * 256 + lane * 4);
      }
    }
  };
  if (gw < R) loadrow(gw, tv, hv);
  if (gw + nw < R) loadrow(gw + nw, tvn, hvn);
  for (int row = gw; row < R; row += nw) {
    if (row + 2 * nw < R) loadrow(row + 2 * nw, tvm, hvm);
    float* hr = hrow_ptr(p, row);
    if (mode != 0) {
      float ss = 0.f;
#pragma unroll
      for (int q = 0; q < 4; ++q) ss += tv[q].x * tv[q].x + tv[q].y * tv[q].y + tv[q].z * tv[q].z + tv[q].w * tv[q].w;
      ss = wave_sum(ss);
      const float rs = rsqrtf(ss * (1.f / D) + EPS);
#pragma unroll
      for (int q = 0; q < 4; ++q) {
        hv[q].x += tv[q].x * rs * wpo[q].x;
        hv[q].y += tv[q].y * rs * wpo[q].y;
        hv[q].z += tv[q].z * rs * wpo[q].z;
        hv[q].w += tv[q].w * rs * wpo[q].w;
      }
    }
#pragma unroll
    for (int q = 0; q < 4; ++q) *reinterpret_cast<float4*>(hr + q * 256 + lane * 4) = hv[q];
    if (write_hn) {
      float ss = 0.f;
#pragma unroll
      for (int q = 0; q < 4; ++q) ss += hv[q].x * hv[q].x + hv[q].y * hv[q].y + hv[q].z * hv[q].z + hv[q].w * hv[q].w;
      ss = wave_sum(ss);
      const float rs = rsqrtf(ss * (1.f / D) + EPS);
#pragma unroll
      for (int q = 0; q < 4; ++q) {
        uint2 o;
        o.x = pack2(hv[q].x * rs * wpr[q].x, hv[q].y * rs * wpr[q].y);
        o.y = pack2(hv[q].z * rs * wpr[q].z, hv[q].w * rs * wpr[q].w);
        *reinterpret_cast<uint2*>(hn + (size_t)row * D + q * 256 + lane * 4) = o;
      }
    }
#pragma unroll
    for (int q = 0; q < 4; ++q) { tv[q] = tvn[q]; hv[q] = hvn[q]; tvn[q] = tvm[q]; hvn[q] = hvm[q]; }
  }
}

constexpr size_t WS_W2T = WS_WA - 196608;
constexpr size_t WS_A2T = WS_W2T + 32768;
constexpr size_t WS_G2T = WS_A2T + 32768;
constexpr size_t WS_WAT = WS_G2T + 65536;
constexpr size_t WS_WXT = WS_WAT + 32768;
static_assert(WS_W2T >= WS_ROPE + (size_t)T * 16 * 8, "small weights overlap rope");
constexpr int LSTR = 264;

constexpr int PMS = 516;
__device__ __forceinline__ float tanh_fast(float x) { return 1.f - 2.f * __builtin_amdgcn_rcpf(1.f + __expf(2.f * x)); }
__device__ __forceinline__ float softplus_fast(float x) { return fmaxf(x, 0.f) + __logf(1.f + __expf(-fabsf(x))); }
__device__ __forceinline__ uint2 ld_u2(const bf16_t* q) { return *reinterpret_cast<const uint2*>(q); }

__device__ __forceinline__ void prep_unit(CP p, int l, int u, char* smem) {
  float* pm = (float*)smem;
  bf16_t* latA = (bf16_t*)(smem + 16 * PMS * 4);
  bf16_t* xcA = latA + 16 * LSTR;
  const int tid = tidx(), lane = tid & 63, wid = tid >> 6, fr = lane & 15, fq = lane >> 4;
  const int b = u / 129, t0 = (u % 129) * 16;
  const int r0 = rowof(b, t0);
  const bf16_t* proj = (const bf16_t*)(p.ws + WS_PROJ);
  bf16_t* RW = (bf16_t*)(p.ws + WS_RW);
  bf16_t* SS = (bf16_t*)(p.ws + WS_SS);
  bf16_t* LR = (bf16_t*)(p.ws + WS_LR);
  bf16_t* RG = (bf16_t*)(p.ws + WS_RG);
  float* RC = (float*)(p.ws + WS_RC);
  float* SD = (float*)(p.ws + WS_SD);
  const int rm1 = (t0 > 0) ? rowof(b, t0 - 1) : 0, rm2 = (t0 > 0) ? rowof(b, t0 - 2) : 0, rm3 = (t0 > 0) ? rowof(b, t0 - 3) : 0;
  const float pz = (t0 > 0) ? 1.f : 0.f;
  half_barrier(smem);
  unsigned ra[2][17];
  unsigned rc[3][19];
  int coff[3];
#pragma unroll
  for (int q = 0; q < 2; ++q) {
    const int col = 2 * tid + q * 512;
    ra[q][0] = *reinterpret_cast<const unsigned*>(proj + (size_t)rm1 * PJ + OFF_RW + col);
#pragma unroll
    for (int tt = 0; tt < 16; ++tt) ra[q][1 + tt] = *reinterpret_cast<const unsigned*>(proj + (size_t)(r0 + tt) * PJ + OFF_RW + col);
  }
#pragma unroll
  for (int q = 0; q < 3; ++q) {
    const bool is_lru = (q == 2);
    const int pr = is_lru ? (tid & 127) : ((tid + q * 256) % 384);
    coff[q] = (is_lru ? OFF_LRU : OFF_XBC) + 2 * pr;
    rc[q][0] = *reinterpret_cast<const unsigned*>(proj + (size_t)rm3 * PJ + coff[q]);
    rc[q][1] = *reinterpret_cast<const unsigned*>(proj + (size_t)rm2 * PJ + coff[q]);
    rc[q][2] = *reinterpret_cast<const unsigned*>(proj + (size_t)rm1 * PJ + coff[q]);
#pragma unroll
    for (int tt = 0; tt < 16; ++tt) rc[q][3 + tt] = *reinterpret_cast<const unsigned*>(proj + (size_t)(r0 + tt) * PJ + coff[q]);
  }
  const bf16_t dtraw = proj[(size_t)(r0 + ((tid >> 2) & 15)) * PJ + OFF_DT + (tid & 3)];
  {
    const float* mu = p.in[14] + l * 1024;
#pragma unroll
    for (int q = 0; q < 2; ++q) {
      const int col = 2 * tid + q * 512;
      const float2 m = *reinterpret_cast<const float2*>(mu + col);
      const unsigned pw = ra[q][0];
      float p0 = pz * lo2f(pw), p1 = pz * hi2f(pw);
#pragma unroll
      for (int tt = 0; tt < 16; ++tt) {
        const unsigned cw_ = ra[q][1 + tt];
        const float c0 = lo2f(cw_), c1 = hi2f(cw_);
        const float v0 = c0 + (p0 - c0) * m.x, v1 = c1 + (p1 - c1) * m.y;
        p0 = c0; p1 = c1;
        if (q == 0) {
          *reinterpret_cast<float2*>(pm + tt * PMS + col) = make_float2(v0, v1);
        } else if (tid < 128) {
          *reinterpret_cast<unsigned*>(RW + (size_t)(r0 + tt) * 1536 + 1280 + 2 * tid) = pack2(v0, v1);
        } else {
          const int i = 2 * (tid - 128);
          float a0, a1;
          if (i < 64) { a0 = tanh_fast(v0); a1 = tanh_fast(v1); }
          else if (i < 128) { a0 = v0; a1 = v1; }
          else { a0 = sigmoidf_(v0); a1 = sigmoidf_(v1); }
          *reinterpret_cast<unsigned*>(latA + tt * LSTR + i) = pack2(a0, a1);
        }
      }
    }
  }
  {
#pragma unroll
    for (int q = 0; q < 3; ++q) {
      const bool is_lru = (q == 2);
      const int pr = is_lru ? tid : tid + q * 256;
      const bool act = is_lru ? (tid < 128) : (pr < 384);
      if (act) {
        const int ch = 2 * pr;
        const int C = is_lru ? 256 : 768;
        const float* cw = is_lru ? (p.in[25] + l * 4 * 256) : (p.in[8] + l * 4 * 768);
        const float2 cb = *reinterpret_cast<const float2*>((is_lru ? p.in[26] + l * 256 : p.in[9] + l * 768) + ch);
        const float2 w0 = *reinterpret_cast<const float2*>(cw + ch), w1 = *reinterpret_cast<const float2*>(cw + C + ch);
        const float2 w2 = *reinterpret_cast<const float2*>(cw + 2 * C + ch), w3 = *reinterpret_cast<const float2*>(cw + 3 * C + ch);
        const unsigned u0 = rc[q][0], u1 = rc[q][1], u2 = rc[q][2];
        float x0a = pz * lo2f(u0), x0b = pz * hi2f(u0), x1a = pz * lo2f(u1), x1b = pz * hi2f(u1), x2a = pz * lo2f(u2), x2b = pz * hi2f(u2);
#pragma unroll
        for (int tt = 0; tt < 16; ++tt) {
          const unsigned u3 = rc[q][3 + tt];
          const float x3a = lo2f(u3), x3b = hi2f(u3);
          const float ya = cb.x + w0.x * x0a + w1.x * x1a + w2.x * x2a + w3.x * x3a;
          const float yb = cb.y + w0.y * x0b + w1.y * x1b + w2.y * x2b + w3.y * x3b;
          if (is_lru) *reinterpret_cast<unsigned*>(xcA + tt * LSTR + ch) = pack2(ya, yb);
          else *reinterpret_cast<unsigned*>(SS + (size_t)(r0 + tt) * 768 + ch) = pack2(siluf_(ya), siluf_(yb));
          x0a = x1a; x0b = x1b; x1a = x2a; x1b = x2b; x2a = x3a; x2b = x3b;
        }
      }
    }
    if (tid < 64) {
      const int tt = tid >> 2, hh = tid & 3;
      const float v = bf2f(dtraw) + p.in[10][l * 4 + hh];
      SD[(size_t)(r0 + tt) * 4 + hh] = softplus_fast(v);
    }
  }
  half_barrier(smem);
  f32x4 accw[4], acca[4], accg[4], accr[4], acci[4];
#pragma unroll
  for (int mf = 0; mf < 4; ++mf) {
    accw[mf] = f32x4{0.f, 0.f, 0.f, 0.f}; acca[mf] = accw[mf]; accg[mf] = accw[mf]; accr[mf] = accw[mf]; acci[mf] = accw[mf];
  }
  {
    const bf16_t* W2T = (const bf16_t*)(p.ws + WS_W2T);
    const bf16_t* A2T = (const bf16_t*)(p.ws + WS_A2T);
    const bf16_t* G2T = (const bf16_t*)(p.ws + WS_G2T);
    const bf16_t* WAT = (const bf16_t*)(p.ws + WS_WAT);
    const bf16_t* WXT = (const bf16_t*)(p.ws + WS_WXT);
    bf16x8 al[8], ax[2];
#pragma unroll
    for (int ks = 0; ks < 8; ++ks) al[ks] = *reinterpret_cast<const bf16x8*>(latA + fr * LSTR + ks * 32 + fq * 8);
#pragma unroll
    for (int ks = 0; ks < 2; ++ks) ax[ks] = *reinterpret_cast<const bf16x8*>(xcA + fr * LSTR + wid * 64 + ks * 32 + fq * 8);
#pragma unroll
    for (int mf = 0; mf < 4; ++mf) {
      const int n = wid * 64 + mf * 16 + fr;
#pragma unroll
      for (int ks = 0; ks < 2; ++ks) {
        const bf16x8 bw = *reinterpret_cast<const bf16x8*>(W2T + n * 64 + ks * 32 + fq * 8);
        const bf16x8 ba = *reinterpret_cast<const bf16x8*>(A2T + n * 64 + ks * 32 + fq * 8);
        const bf16x8 br = *reinterpret_cast<const bf16x8*>(WAT + n * 64 + ks * 32 + fq * 8);
        const bf16x8 bi = *reinterpret_cast<const bf16x8*>(WXT + n * 64 + ks * 32 + fq * 8);
        accw[mf] = __builtin_amdgcn_mfma_f32_16x16x32_bf16(bw, al[ks], accw[mf], 0, 0, 0);
        acca[mf] = __builtin_amdgcn_mfma_f32_16x16x32_bf16(ba, al[2 + ks], acca[mf], 0, 0, 0);
        accr[mf] = __builtin_amdgcn_mfma_f32_16x16x32_bf16(br, ax[ks], accr[mf], 0, 0, 0);
        acci[mf] = __builtin_amdgcn_mfma_f32_16x16x32_bf16(bi, ax[ks], acci[mf], 0, 0, 0);
      }
#pragma unroll
      for (int ks = 0; ks < 4; ++ks) {
        const bf16x8 bg = *reinterpret_cast<const bf16x8*>(G2T + n * 128 + ks * 32 + fq * 8);
        accg[mf] = __builtin_amdgcn_mfma_f32_16x16x32_bf16(bg, al[4 + ks], accg[mf], 0, 0, 0);
      }
    }
  }
  {
    const int tt = fr;
    const size_t row = (size_t)(r0 + tt);
    float kkv[16], kpv[16], avv[16], rv[16];
    float ss = 0.f, cf = 0.f;
#pragma unroll
    for (int mf = 0; mf < 4; ++mf) {
      const int c = wid * 64 + mf * 16 + fq * 4;
      const float4 r4 = *reinterpret_cast<const float4*>(pm + tt * PMS + c);
      const float4 k4 = *reinterpret_cast<const float4*>(pm + tt * PMS + 256 + c);
      const float4 a0 = *reinterpret_cast<const float4*>(p.in[17] + l * 256 + c);
      const float4 kkc = *reinterpret_cast<const float4*>(p.in[20] + l * 256 + c);
      const float4 kac = *reinterpret_cast<const float4*>(p.in[21] + l * 256 + c);
      const float4 rkc = *reinterpret_cast<const float4*>(p.in[22] + l * 256 + c);
      const float rr_[4] = {r4.x, r4.y, r4.z, r4.w}, kk_[4] = {k4.x, k4.y, k4.z, k4.w};
      const float a0_[4] = {a0.x, a0.y, a0.z, a0.w}, kkc_[4] = {kkc.x, kkc.y, kkc.z, kkc.w};
      const float kac_[4] = {kac.x, kac.y, kac.z, kac.w}, rkc_[4] = {rkc.x, rkc.y, rkc.z, rkc.w};
#pragma unroll
      for (int j = 0; j < 4; ++j) {
        const int x = mf * 4 + j;
        rv[x] = rr_[j];
        avv[x] = sigmoidf_(a0_[j] + acca[mf][j]);
        kkv[x] = kk_[j] * kkc_[j];
        ss += kkv[x] * kkv[x];
        kpv[x] = kk_[j] * (1.f + (avv[x] - 1.f) * kac_[j]);
        cf += rv[x] * kpv[x] * rkc_[j];
      }
    }
    ss += __shfl_xor(ss, 16, 64); ss += __shfl_xor(ss, 32, 64);
    cf += __shfl_xor(cf, 16, 64); cf += __shfl_xor(cf, 32, 64);
    const float inv = 1.f / fmaxf(sqrtf(ss), 1e-12f);
    float4 w0a[4], baa[4], bxa[4], lama[4];
#pragma unroll
    for (int mf = 0; mf < 4; ++mf) {
      const int c = wid * 64 + mf * 16 + fq * 4;
      w0a[mf] = *reinterpret_cast<const float4*>(p.in[15] + l * 256 + c);
      baa[mf] = *reinterpret_cast<const float4*>(p.in[28] + l * 256 + c);
      bxa[mf] = *reinterpret_cast<const float4*>(p.in[30] + l * 256 + c);
      lama[mf] = *reinterpret_cast<const float4*>(p.in[31] + l * 256 + c);
    }
    if (fq == 0) RC[row * 4 + wid] = cf;
#pragma unroll
    for (int mf = 0; mf < 4; ++mf) {
      const int c = wid * 64 + mf * 16 + fq * 4;
      const float4 w0 = w0a[mf], ba = baa[mf], bx = bxa[mf], lam = lama[mf];
      const float w0_[4] = {w0.x, w0.y, w0.z, w0.w}, ba_[4] = {ba.x, ba.y, ba.z, ba.w};
      const float bx_[4] = {bx.x, bx.y, bx.z, bx.w}, lam_[4] = {lam.x, lam.y, lam.z, lam.w};
      const uint2 xcr = *reinterpret_cast<const uint2*>(xcA + tt * LSTR + c);
      const float xc_[4] = {lo2f(xcr.x), hi2f(xcr.x), lo2f(xcr.y), hi2f(xcr.y)};
      float omw[4], kn[4], bb[4], la[4], uu[4];
#pragma unroll
      for (int j = 0; j < 4; ++j) {
        const int x = mf * 4 + j;
        const float wv = w0_[j] + accw[mf][j];
        const float w = -softplus_fast(-wv) - 0.5f;
        omw[j] = 1.f - __expf(-__expf(w));
        kn[j] = kkv[x] * inv;
        bb[j] = kn[j] * avv[x];
        const float rr = sigmoidf_(accr[mf][j] + ba_[j]), ii = sigmoidf_(acci[mf][j] + bx_[j]);
        la[j] = -8.f * rr * softplus_fast(-lam_[j]);
        uu[j] = sqrtf(fmaxf(1.f - __expf(2.f * la[j]), 0.f)) * (ii * xc_[j]);
      }
      bf16_t* o = RW + row * 1536 + c;
      *reinterpret_cast<uint2*>(o) = make_uint2(pack2(omw[0], omw[1]), pack2(omw[2], omw[3]));
      *reinterpret_cast<uint2*>(o + 256) = make_uint2(pack2(kn[0], kn[1]), pack2(kn[2], kn[3]));
      *reinterpret_cast<uint2*>(o + 512) = make_uint2(pack2(bb[0], bb[1]), pack2(bb[2], bb[3]));
      *reinterpret_cast<uint2*>(o + 768) = make_uint2(pack2(kpv[mf * 4], kpv[mf * 4 + 1]), pack2(kpv[mf * 4 + 2], kpv[mf * 4 + 3]));
      *reinterpret_cast<uint2*>(o + 1024) = make_uint2(pack2(rv[mf * 4], rv[mf * 4 + 1]), pack2(rv[mf * 4 + 2], rv[mf * 4 + 3]));
      *reinterpret_cast<uint2*>(RG + row * 256 + c) = make_uint2(pack2(accg[mf][0], accg[mf][1]), pack2(accg[mf][2], accg[mf][3]));
      *reinterpret_cast<uint2*>(LR + row * 512 + c) = make_uint2(pack2(la[0], la[1]), pack2(la[2], la[3]));
      *reinterpret_cast<uint2*>(LR + row * 512 + 256 + c) = make_uint2(pack2(uu[0], uu[1]), pack2(uu[2], uu[3]));
    }
  }
}

__device__ __forceinline__ void rwkv_scan_unit(CP p, int u, char* smem) {
  float* buf = (float*)smem;
  const int tid = tidx(), wid = tid >> 6, lane = tid & 63, i = lane >> 4, j = lane & 15;
  const int b = u >> 4, h = (u >> 2) & 3, q = u & 3;
  const int rowv = q * 16 + wid * 4 + i;
  const bf16_t* RW = (const bf16_t*)(p.ws + WS_RW);
  bf16_t* Y = (bf16_t*)(p.ws + WS_Y);
  float s0 = 0.f, s1 = 0.f, s2 = 0.f, s3 = 0.f;
  uint4 st[3];
  auto gload = [&](int c) {
    const int rb = rowof(b, c * 16);
#pragma unroll
    for (int x = 0; x < 3; ++x) {
      const int e = tid + x * 256, tok = e / 48, rem = e % 48, vec = rem >> 3, part = rem & 7;
      st[x] = *reinterpret_cast<const uint4*>(RW + (size_t)(rb + tok) * 1536 + vec * 256 + h * 64 + part * 8);
    }
  };
  auto lwrite = [&](int bi) {
#pragma unroll
    for (int x = 0; x < 3; ++x) {
      const int e = tid + x * 256, tok = e / 48, rem = e % 48, vec = rem >> 3, part = rem & 7;
      float* d = buf + bi * 6144 + tok * 384 + vec * 64 + part * 8;
      *reinterpret_cast<float4*>(d) = make_float4(lo2f(st[x].x), hi2f(st[x].x), lo2f(st[x].y), hi2f(st[x].y));
      *reinterpret_cast<float4*>(d + 4) = make_float4(lo2f(st[x].z), hi2f(st[x].z), lo2f(st[x].w), hi2f(st[x].w));
    }
  };
  half_barrier(smem);
  gload(0);
  lwrite(0);
  half_barrier(smem);
  constexpr int NCH = T / 16;
  for (int c = 0; c < NCH; ++c) {
    if (c + 1 < NCH) gload(c + 1);
    const float* cb = buf + (c & 1) * 6144;
    float ykeep = 0.f;
    float4 om = *reinterpret_cast<const float4*>(cb + j * 4);
    float4 kk = *reinterpret_cast<const float4*>(cb + 64 + j * 4);
    float4 bb = *reinterpret_cast<const float4*>(cb + 128 + j * 4);
    float4 kp = *reinterpret_cast<const float4*>(cb + 192 + j * 4);
    float4 rr = *reinterpret_cast<const float4*>(cb + 256 + j * 4);
    float vv = cb[320 + rowv];
#pragma unroll 2
    for (int s = 0; s < 16; ++s) {
      const float* sb = cb + (s + 1) * 384;
      const float4 om_n = *reinterpret_cast<const float4*>(sb + j * 4);
      const float4 kk_n = *reinterpret_cast<const float4*>(sb + 64 + j * 4);
      const float4 bb_n = *reinterpret_cast<const float4*>(sb + 128 + j * 4);
      const float4 kp_n = *reinterpret_cast<const float4*>(sb + 192 + j * 4);
      const float4 rr_n = *reinterpret_cast<const float4*>(sb + 256 + j * 4);
      const float vv_n = sb[320 + rowv];
      __builtin_amdgcn_sched_barrier(0);
      float d = s0 * kk.x + s1 * kk.y + s2 * kk.z + s3 * kk.w;
      d = allreduce16(d);
      const float sa = -d;
      s0 = fmaf(-s0, om.x, s0); s1 = fmaf(-s1, om.y, s1); s2 = fmaf(-s2, om.z, s2); s3 = fmaf(-s3, om.w, s3);
      s0 = fmaf(sa, bb.x, s0); s1 = fmaf(sa, bb.y, s1); s2 = fmaf(sa, bb.z, s2); s3 = fmaf(sa, bb.w, s3);
      s0 = fmaf(vv, kp.x, s0); s1 = fmaf(vv, kp.y, s1); s2 = fmaf(vv, kp.z, s2); s3 = fmaf(vv, kp.w, s3);
      float y = s0 * rr.x + s1 * rr.y + s2 * rr.z + s3 * rr.w;
      y = allreduce16(y);
      if (j == s) ykeep = y;
      om = om_n; kk = kk_n; bb = bb_n; kp = kp_n; rr = rr_n; vv = vv_n;
    }
    Y[(size_t)(rowof(b, c * 16) + j) * 1024 + 256 + h * 64 + rowv] = f2bf(ykeep);
    if (c + 1 < NCH) lwrite((c + 1) & 1);
    half_barrier(smem);
  }
}

__device__ __forceinline__ void ssd_scan_unit(CP p, int l, int u, char* smem) {
  constexpr int SST = 296;
  float* buf = (float*)smem;
  const int tid = tidx(), wid = tid >> 6, lane = tid & 63, i = lane >> 4, j = lane & 15;
  const int b = u >> 4, h = (u >> 2) & 3, q = u & 3, g = h >> 1;
  const int prow = wid * 4 + i;
  const bf16_t* SS = (const bf16_t*)(p.ws + WS_SS);
  const float* SD = (const float*)(p.ws + WS_SD);
  bf16_t* Y = (bf16_t*)(p.ws + WS_Y);
  const float Ah = -__expf(p.in[11][l * 4 + h]);
  const float Dh = p.in[12][l * 4 + h];
  float hs[8];
#pragma unroll
  for (int n = 0; n < 8; ++n) hs[n] = 0.f;
  uint4 st[2];
  unsigned short stxr = 0;
  float stdt = 0.f;
  auto gload = [&](int c) {
    const int rb = rowof(b, c * 16);
#pragma unroll
    for (int x = 0; x < 2; ++x) {
      const int e = tid + x * 256, tok = e >> 5, rem = e & 31, which = rem >> 4, part = rem & 15;
      st[x] = *reinterpret_cast<const uint4*>(SS + (size_t)(rb + tok) * 768 + 256 + which * 256 + g * 128 + part * 8);
    }
    {
      const int tok = tid >> 4, pp = tid & 15;
      stxr = SS[(size_t)(rb + tok) * 768 + h * 64 + q * 16 + pp];
      stdt = SD[(size_t)(rb + tok) * 4 + h];
    }
  };
  auto lwrite = [&](int bi) {
#pragma unroll
    for (int x = 0; x < 2; ++x) {
      const int e = tid + x * 256, tok = e >> 5, rem = e & 31, which = rem >> 4, part = rem & 15;
      float* d = buf + bi * 16 * SST + tok * SST + which * 128 + part * 8;
      *reinterpret_cast<float4*>(d) = make_float4(lo2f(st[x].x), hi2f(st[x].x), lo2f(st[x].y), hi2f(st[x].y));
      *reinterpret_cast<float4*>(d + 4) = make_float4(lo2f(st[x].z), hi2f(st[x].z), lo2f(st[x].w), hi2f(st[x].w));
    }
    {
      const int tok = tid >> 4, pp = tid & 15;
      float* d = buf + bi * 16 * SST + tok * SST;
      const float stx = bf2f(stxr);
      d[256 + pp] = stx * stdt;
      d[272 + pp] = stx;
      if (pp == 0) d[288] = __expf(stdt * Ah);
    }
  };
  half_barrier(smem);
  gload(0);
  lwrite(0);
  half_barrier(smem);
  constexpr int NCH = T / 16;
  for (int c = 0; c < NCH; ++c) {
    if (c + 1 < NCH) gload(c + 1);
    const float* cb = buf + (c & 1) * 16 * SST;
    float ykeep = 0.f;
    float4 B0 = *reinterpret_cast<const float4*>(cb + j * 4), B1 = *reinterpret_cast<const float4*>(cb + 64 + j * 4);
    float4 C0 = *reinterpret_cast<const float4*>(cb + 128 + j * 4), C1 = *reinterpret_cast<const float4*>(cb + 192 + j * 4);
    float xdt = cb[256 + prow], xr = cb[272 + prow], a = cb[288];
#pragma unroll 2
    for (int s = 0; s < 16; ++s) {
      const float* sb = cb + (s + 1) * SST;
      const float4 B0n = *reinterpret_cast<const float4*>(sb + j * 4), B1n = *reinterpret_cast<const float4*>(sb + 64 + j * 4);
      const float4 C0n = *reinterpret_cast<const float4*>(sb + 128 + j * 4), C1n = *reinterpret_cast<const float4*>(sb + 192 + j * 4);
      const float xdtn = sb[256 + prow], xrn = sb[272 + prow], an = sb[288];
      __builtin_amdgcn_sched_barrier(0);
      hs[0] = fmaf(a, hs[0], xdt * B0.x); hs[1] = fmaf(a, hs[1], xdt * B0.y); hs[2] = fmaf(a, hs[2], xdt * B0.z); hs[3] = fmaf(a, hs[3], xdt * B0.w);
      hs[4] = fmaf(a, hs[4], xdt * B1.x); hs[5] = fmaf(a, hs[5], xdt * B1.y); hs[6] = fmaf(a, hs[6], xdt * B1.z); hs[7] = fmaf(a, hs[7], xdt * B1.w);
      float y = hs[0] * C0.x + hs[1] * C0.y + hs[2] * C0.z + hs[3] * C0.w + hs[4] * C1.x + hs[5] * C1.y + hs[6] * C1.z + hs[7] * C1.w;
      y = allreduce16(y);
      y = fmaf(Dh, xr, y);
      if (j == s) ykeep = y;
      B0 = B0n; B1 = B1n; C0 = C0n; C1 = C1n; xdt = xdtn; xr = xrn; a = an;
    }
    Y[(size_t)(rowof(b, c * 16) + j) * 1024 + h * 64 + q * 16 + prow] = f2bf(ykeep);
    if (c + 1 < NCH) lwrite((c + 1) & 1);
    half_barrier(smem);
  }
}

__device__ __forceinline__ void ret_scan_unit(CP p, int l, int u, char* smem) {
  float* buf = (float*)smem;
  float* ybuf0 = buf + 2 * 16 * 128;
  const int tid = tidx(), e = tid >> 2, dsl = tid & 3;
  const int b = u >> 2, h = u & 3;
  const bf16_t* proj = (const bf16_t*)(p.ws + WS_PROJ);
  const float* rope = (const float*)(p.ws + WS_ROPE);
  bf16_t* Y = (bf16_t*)(p.ws + WS_Y);
  const float gdec = 1.f - exp2f(-5.f - (float)h);
  float S[8];
#pragma unroll
  for (int n = 0; n < 8; ++n) S[n] = 0.f;
  const int stok = tid >> 4, spart = tid & 15;
  uint4 sa_, sb_;
  float4 rp0, rp1, rp2, rp3;
  uint2 gg_n, gg_c;
  const int s_qk = (spart >> 2) & 1, s_pp = spart & 3;
  const int offa = (spart < 8) ? (OFF_RET + s_qk * 128 + h * 32 + s_pp * 8) : (OFF_RET + 256 + h * 64 + (spart - 8) * 8);
  const int offb = (spart < 8) ? (OFF_RET + s_qk * 128 + h * 32 + (s_pp ^ 2) * 8) : offa;
  const int ech = h * 64 + spart * 4;
  const float4 gw = *reinterpret_cast<const float4*>(p.in[32] + l * 256 + ech);
  auto gload = [&](int c) {
    const size_t row = (size_t)(rowof(b, c * 16) + stok);
    sa_ = *reinterpret_cast<const uint4*>(proj + row * PJ + offa);
    sb_ = *reinterpret_cast<const uint4*>(proj + row * PJ + offb);
    const float* rpp = rope + ((size_t)(c * 16 + stok) * 16 + (s_pp & 1) * 8) * 2;
    rp0 = *reinterpret_cast<const float4*>(rpp);
    rp1 = *reinterpret_cast<const float4*>(rpp + 4);
    rp2 = *reinterpret_cast<const float4*>(rpp + 8);
    rp3 = *reinterpret_cast<const float4*>(rpp + 12);
    gg_n = *reinterpret_cast<const uint2*>(proj + row * PJ + OFF_RET + 512 + ech);
  };
  auto lwrite = [&](int bi) {
    float* d = buf + bi * 2048 + stok * 128;
    float a[8];
    a[0] = lo2f(sa_.x); a[1] = hi2f(sa_.x); a[2] = lo2f(sa_.y); a[3] = hi2f(sa_.y);
    a[4] = lo2f(sa_.z); a[5] = hi2f(sa_.z); a[6] = lo2f(sa_.w); a[7] = hi2f(sa_.w);
    if (spart < 8) {
      float o[8];
      o[0] = lo2f(sb_.x); o[1] = hi2f(sb_.x); o[2] = lo2f(sb_.y); o[3] = hi2f(sb_.y);
      o[4] = lo2f(sb_.z); o[5] = hi2f(sb_.z); o[6] = lo2f(sb_.w); o[7] = hi2f(sb_.w);
      const float cs[16] = {rp0.x, rp0.y, rp0.z, rp0.w, rp1.x, rp1.y, rp1.z, rp1.w, rp2.x, rp2.y, rp2.z, rp2.w, rp3.x, rp3.y, rp3.z, rp3.w};
      const float sc = s_qk ? 0.17677669529663687f : 1.f;
      float r[8];
#pragma unroll
      for (int n = 0; n < 8; ++n) {
        r[n] = (s_pp < 2) ? (a[n] * cs[2 * n] - o[n] * cs[2 * n + 1]) : (o[n] * cs[2 * n + 1] + a[n] * cs[2 * n]);
        r[n] *= sc;
      }
      float* dd = d + s_qk * 32 + s_pp * 8;
      *reinterpret_cast<float4*>(dd) = make_float4(r[0], r[1], r[2], r[3]);
      *reinterpret_cast<float4*>(dd + 4) = make_float4(r[4], r[5], r[6], r[7]);
    } else {
      float* dd = d + 64 + (spart - 8) * 8;
      *reinterpret_cast<float4*>(dd) = make_float4(a[0], a[1], a[2], a[3]);
      *reinterpret_cast<float4*>(dd + 4) = make_float4(a[4], a[5], a[6], a[7]);
    }
  };
  half_barrier(smem);
  gload(0);
  lwrite(0);
  gg_c = gg_n;
  half_barrier(smem);
  constexpr int NCH = T / 16;
  for (int c = 0; c < NCH; ++c) {
    if (c + 1 < NCH) gload(c + 1);
    const float* cb = buf + (c & 1) * 2048;
    float* ybuf = ybuf0 + (c & 1) * 1024;
    float4 q0 = *reinterpret_cast<const float4*>(cb + dsl * 8), q1 = *reinterpret_cast<const float4*>(cb + dsl * 8 + 4);
    float4 k0 = *reinterpret_cast<const float4*>(cb + 32 + dsl * 8), k1 = *reinterpret_cast<const float4*>(cb + 32 + dsl * 8 + 4);
    float v = cb[64 + e];
#pragma unroll 2
    for (int s = 0; s < 16; ++s) {
      const float* sb = cb + (s + 1) * 128;
      const float4 q0n = *reinterpret_cast<const float4*>(sb + dsl * 8), q1n = *reinterpret_cast<const float4*>(sb + dsl * 8 + 4);
      const float4 k0n = *reinterpret_cast<const float4*>(sb + 32 + dsl * 8), k1n = *reinterpret_cast<const float4*>(sb + 32 + dsl * 8 + 4);
      const float vn = sb[64 + e];
      __builtin_amdgcn_sched_barrier(0);
      S[0] = fmaf(gdec, S[0], k0.x * v); S[1] = fmaf(gdec, S[1], k0.y * v); S[2] = fmaf(gdec, S[2], k0.z * v); S[3] = fmaf(gdec, S[3], k0.w * v);
      S[4] = fmaf(gdec, S[4], k1.x * v); S[5] = fmaf(gdec, S[5], k1.y * v); S[6] = fmaf(gdec, S[6], k1.z * v); S[7] = fmaf(gdec, S[7], k1.w * v);
      float y = S[0] * q0.x + S[1] * q0.y + S[2] * q0.z + S[3] * q0.w + S[4] * q1.x + S[5] * q1.y + S[6] * q1.z + S[7] * q1.w;
      y = allreduce4(y);
      ybuf[s * 64 + e] = y;
      q0 = q0n; q1 = q1n; k0 = k0n; k1 = k1n; v = vn;
    }
    if (c + 1 < NCH) lwrite((c + 1) & 1);
    half_barrier(smem);
    {
      const float4 yv = *reinterpret_cast<const float4*>(ybuf + stok * 64 + spart * 4);
      const float mu = allreduce16(yv.x + yv.y + yv.z + yv.w) * (1.f / 64.f);
      const float d0 = yv.x - mu, d1 = yv.y - mu, d2 = yv.z - mu, d3 = yv.w - mu;
      const float var = allreduce16(d0 * d0 + d1 * d1 + d2 * d2 + d3 * d3) * (1.f / 64.f);
      const float rs = rsqrtf(var + 1e-5f);
      const size_t row = (size_t)(rowof(b, c * 16) + stok);
      uint2 o;
      o.x = pack2(d0 * rs * gw.x * siluf_(lo2f(gg_c.x)), d1 * rs * gw.y * siluf_(hi2f(gg_c.x)));
      o.y = pack2(d2 * rs * gw.z * siluf_(lo2f(gg_c.y)), d3 * rs * gw.w * siluf_(hi2f(gg_c.y)));
      *reinterpret_cast<uint2*>(Y + row * 1024 + 768 + ech) = o;
    }
    gg_c = gg_n;
  }
}


__device__ __forceinline__ void ret_mfma_unit(CP p, int l, int u, char* smem) {
  const int tid = tidx(), wv = tid >> 6, lane = tid & 63, r = lane & 15, fq = lane >> 4;
  const int bh = u * 2 + (wv >> 1), b = bh >> 2, h = bh & 3, eh = wv & 1;
  char* wl = smem + wv * 8192;
  bf16_t* KT = (bf16_t*)wl;
  bf16_t* VT = (bf16_t*)(wl + 1024);
  bf16_t* PT = (bf16_t*)(wl + 3072);
  bf16_t* ST = (bf16_t*)(wl + 4096);
  const bf16_t* proj = (const bf16_t*)(p.ws + WS_PROJ);
  const float* rope = (const float*)(p.ws + WS_ROPE);
  bf16_t* Y = (bf16_t*)(p.ws + WS_Y);
  half_barrier(smem);
  for (int i = lane; i < 512; i += 64) reinterpret_cast<unsigned*>(ST)[i] = 0u;
  const float lg = log2f(1.f - exp2f(-5.f - (float)h));
  const float dk = exp2f(lg * (float)(15 - r)), dq = exp2f(lg * (float)(r + 1)), d16 = exp2f(lg * 16.f);
  float pw[4];
#pragma unroll
  for (int jj = 0; jj < 4; ++jj) { const int t = fq * 4 + jj; pw[jj] = (r <= t) ? exp2f(lg * (float)(t - r)) : 0.f; }
  f32x4 Sacc[2][2];
#pragma unroll
  for (int mf = 0; mf < 2; ++mf)
#pragma unroll
    for (int nf = 0; nf < 2; ++nf) Sacc[mf][nf] = f32x4{0.f, 0.f, 0.f, 0.f};
  const bf16x8 zero8 = {0, 0, 0, 0, 0, 0, 0, 0};
  const bool lowk = fq < 2;
  uint4 qa, qb, ka, kb, v0, nqa, nqb, nka, nkb, nv0, mqa, mqb, mka, mkb, mv0;
  float4 rp0, rp1, rp2, rp3, nrp0, nrp1, nrp2, nrp3;
  constexpr int NCH = T / 16;
#define RET_GLOAD(c, QA, QB, KA, KB, V0) do { \
    const bf16_t* pr_ = proj + (size_t)(rowof(b, (c) * 16) + r) * PJ + OFF_RET; \
    QA = *reinterpret_cast<const uint4*>(pr_ + h * 32 + fq * 8); \
    QB = *reinterpret_cast<const uint4*>(pr_ + h * 32 + (fq ^ 2) * 8); \
    KA = *reinterpret_cast<const uint4*>(pr_ + 128 + h * 32 + fq * 8); \
    KB = *reinterpret_cast<const uint4*>(pr_ + 128 + h * 32 + (fq ^ 2) * 8); \
    V0 = *reinterpret_cast<const uint4*>(pr_ + 256 + h * 64 + eh * 32 + fq * 8); \
  } while (0)
#define RET_ROPE(c, R0, R1, R2, R3) do { \
    const float* rq_ = rope + ((size_t)((c) * 16 + r) * 16 + (fq & 1) * 8) * 2; \
    R0 = *reinterpret_cast<const float4*>(rq_); R1 = *reinterpret_cast<const float4*>(rq_ + 4); \
    R2 = *reinterpret_cast<const float4*>(rq_ + 8); R3 = *reinterpret_cast<const float4*>(rq_ + 12); \
  } while (0)
  RET_GLOAD(0, qa, qb, ka, kb, v0);
  RET_ROPE(0, rp0, rp1, rp2, rp3);
  RET_GLOAD(1, nqa, nqb, nka, nkb, nv0);
  for (int c = 0; c < NCH; ++c) {
    RET_GLOAD((c + 2 < NCH) ? c + 2 : c, mqa, mqb, mka, mkb, mv0);
    RET_ROPE((c + 1 < NCH) ? c + 1 : c, nrp0, nrp1, nrp2, nrp3);
    const float cs[16] = {rp0.x, rp0.y, rp0.z, rp0.w, rp1.x, rp1.y, rp1.z, rp1.w, rp2.x, rp2.y, rp2.z, rp2.w, rp3.x, rp3.y, rp3.z, rp3.w};
    const unsigned qaw[4] = {qa.x, qa.y, qa.z, qa.w}, qbw[4] = {qb.x, qb.y, qb.z, qb.w};
    const unsigned kaw[4] = {ka.x, ka.y, ka.z, ka.w}, kbw[4] = {kb.x, kb.y, kb.z, kb.w};
    float qf[8], kf[8];
#pragma unroll
    for (int n = 0; n < 8; ++n) {
      const float qo = (n & 1) ? hi2f(qaw[n >> 1]) : lo2f(qaw[n >> 1]);
      const float qp = (n & 1) ? hi2f(qbw[n >> 1]) : lo2f(qbw[n >> 1]);
      const float ko = (n & 1) ? hi2f(kaw[n >> 1]) : lo2f(kaw[n >> 1]);
      const float kp = (n & 1) ? hi2f(kbw[n >> 1]) : lo2f(kbw[n >> 1]);
      const float cc = cs[2 * n], sn = cs[2 * n + 1];
      qf[n] = lowk ? (qo * cc - qp * sn) : (qp * sn + qo * cc);
      kf[n] = (lowk ? (ko * cc - kp * sn) : (kp * sn + ko * cc)) * 0.17677669529663687f;
    }
    bf16x8 Qf, Kf, Qs;
#pragma unroll
    for (int n = 0; n < 8; ++n) { Qf[n] = (short)f2bf(qf[n]); Kf[n] = (short)f2bf(kf[n]); Qs[n] = (short)f2bf(qf[n] * dq); }
    f32x4 P = __builtin_amdgcn_mfma_f32_16x16x32_bf16(Qf, Kf, f32x4{0.f, 0.f, 0.f, 0.f}, 0, 0, 0);
#pragma unroll
    for (int jj = 0; jj < 4; ++jj) PT[(fq * 4 + jj) * 16 + r] = f2bf(P[jj] * pw[jj]);
#pragma unroll
    for (int n = 0; n < 8; ++n) KT[(fq * 8 + n) * 16 + r] = f2bf(kf[n] * dk);
    {
      const unsigned vw[4] = {v0.x, v0.y, v0.z, v0.w};
#pragma unroll
      for (int i = 0; i < 8; ++i) VT[(fq * 8 + i) * 16 + r] = (bf16_t)((i & 1) ? (vw[i >> 1] >> 16) : (vw[i >> 1] & 0xffffu));
    }
    asm volatile("s_waitcnt lgkmcnt(0)" ::: "memory");
    bf16x8 Pf = *reinterpret_cast<const bf16x8*>(PT + r * 16 + (fq & 1) * 8);
    Pf = lowk ? Pf : zero8;
    bf16x8 VTf[2], STf[2], KTf[2];
#pragma unroll
    for (int nf = 0; nf < 2; ++nf) {
      VTf[nf] = *reinterpret_cast<const bf16x8*>(VT + (nf * 16 + r) * 16 + (fq & 1) * 8);
      VTf[nf] = lowk ? VTf[nf] : zero8;
      STf[nf] = *reinterpret_cast<const bf16x8*>(ST + (nf * 16 + r) * 32 + fq * 8);
    }
#pragma unroll
    for (int mf = 0; mf < 2; ++mf) {
      KTf[mf] = *reinterpret_cast<const bf16x8*>(KT + (mf * 16 + r) * 16 + (fq & 1) * 8);
      KTf[mf] = lowk ? KTf[mf] : zero8;
    }
    asm volatile("s_waitcnt lgkmcnt(0)" ::: "memory");
    f32x4 Yv[2];
#pragma unroll
    for (int nf = 0; nf < 2; ++nf) {
      Yv[nf] = __builtin_amdgcn_mfma_f32_16x16x32_bf16(Qs, STf[nf], f32x4{0.f, 0.f, 0.f, 0.f}, 0, 0, 0);
      Yv[nf] = __builtin_amdgcn_mfma_f32_16x16x32_bf16(Pf, VTf[nf], Yv[nf], 0, 0, 0);
    }
#pragma unroll
    for (int mf = 0; mf < 2; ++mf)
#pragma unroll
      for (int nf = 0; nf < 2; ++nf) {
        Sacc[mf][nf] = Sacc[mf][nf] * d16;
        Sacc[mf][nf] = __builtin_amdgcn_mfma_f32_16x16x32_bf16(KTf[mf], VTf[nf], Sacc[mf][nf], 0, 0, 0);
        *reinterpret_cast<uint2*>(ST + (nf * 16 + r) * 32 + mf * 16 + fq * 4) =
            make_uint2(pack2(Sacc[mf][nf][0], Sacc[mf][nf][1]), pack2(Sacc[mf][nf][2], Sacc[mf][nf][3]));
      }
    const int rb = rowof(b, c * 16);
#pragma unroll
    for (int jj = 0; jj < 4; ++jj)
#pragma unroll
      for (int nf = 0; nf < 2; ++nf)
        Y[(size_t)(rb + fq * 4 + jj) * 1024 + 768 + h * 64 + eh * 32 + nf * 16 + r] = f2bf(Yv[nf][jj]);
    asm volatile("s_waitcnt lgkmcnt(0)" ::: "memory");
    qa = nqa; qb = nqb; ka = nka; kb = nkb; v0 = nv0;
    nqa = mqa; nqb = mqb; nka = mka; nkb = mkb; nv0 = mv0;
    rp0 = nrp0; rp1 = nrp1; rp2 = nrp2; rp3 = nrp3;
  }
#undef RET_ROPE
#undef RET_GLOAD
}

__device__ __forceinline__ float gelu_tanh(float x) {
  const float u = 0.7978845608028654f * (x + 0.044715f * x * x * x);
  return 0.5f * x * (1.f + tanhf(u));
}
__device__ __forceinline__ void lru_scan_unit(CP p, int u, char* smem) {
  float* segS = (float*)smem;
  float* segH = segS + 256;
  const int tid = tidx(), seg = tid >> 6, lane = tid & 63;
  const int b = u >> 2, ch = (u & 3) * 64 + lane;
  const bf16_t* LR = (const bf16_t*)(p.ws + WS_LR);
  const bf16_t* proj = (const bf16_t*)(p.ws + WS_PROJ);
  bf16_t* Y = (bf16_t*)(p.ws + WS_Y);
  constexpr int SEGL = T / 4;
  const int tb = seg * SEGL;
  half_barrier(smem);
  constexpr int LB = 12, NBAT = SEGL / LB;
  float hl = 0.f, S = 0.f;
  {
    unsigned short la[LB], uu[LB], lan[LB], uun[LB];
#pragma unroll
    for (int x = 0; x < LB; ++x) {
      const size_t row = (size_t)rowof(b, tb + x);
      la[x] = LR[row * 512 + ch]; uu[x] = LR[row * 512 + 256 + ch];
    }
    for (int k = 0; k < NBAT; ++k) {
      const int tn = tb + (k + 1 < NBAT ? k + 1 : k) * LB;
#pragma unroll
      for (int x = 0; x < LB; ++x) {
        const size_t row = (size_t)rowof(b, tn + x);
        lan[x] = LR[row * 512 + ch]; uun[x] = LR[row * 512 + 256 + ch];
      }
#pragma unroll
      for (int x = 0; x < LB; ++x) {
        const float l_ = bf2f(la[x]);
        hl = fmaf(__expf(l_), hl, bf2f(uu[x]));
        S += l_;
      }
#pragma unroll
      for (int x = 0; x < LB; ++x) { la[x] = lan[x]; uu[x] = uun[x]; }
    }
  }
  segS[seg * 64 + lane] = S;
  segH[seg * 64 + lane] = hl;
  half_barrier(smem);
  float hh = 0.f;
  for (int q = 0; q < seg; ++q) hh = fmaf(__expf(segS[q * 64 + lane]), hh, segH[q * 64 + lane]);
  {
    unsigned short la[LB], uu[LB], gb[LB], lan[LB], uun[LB], gbn[LB];
#pragma unroll
    for (int x = 0; x < LB; ++x) {
      const size_t row = (size_t)rowof(b, tb + x);
      la[x] = LR[row * 512 + ch]; uu[x] = LR[row * 512 + 256 + ch]; gb[x] = proj[row * PJ + OFF_LRU + 256 + ch];
    }
    for (int k = 0; k < NBAT; ++k) {
      const int tn = tb + (k + 1 < NBAT ? k + 1 : k) * LB;
#pragma unroll
      for (int x = 0; x < LB; ++x) {
        const size_t row = (size_t)rowof(b, tn + x);
        lan[x] = LR[row * 512 + ch]; uun[x] = LR[row * 512 + 256 + ch]; gbn[x] = proj[row * PJ + OFF_LRU + 256 + ch];
      }
#pragma unroll
      for (int x = 0; x < LB; ++x) {
        hh = fmaf(__expf(bf2f(la[x])), hh, bf2f(uu[x]));
        Y[(size_t)rowof(b, tb + k * LB + x) * 1024 + 512 + ch] = f2bf(hh * gelu_tanh(bf2f(gb[x])));
      }
#pragma unroll
      for (int x = 0; x < LB; ++x) { la[x] = lan[x]; uu[x] = uun[x]; gb[x] = gbn[x]; }
    }
  }
}

__device__ __forceinline__ void epi_phase(CP p, int l) {
  const int tid_ = tidx(); const int lane = tid_ & 63, gw = bidx() * 4 + (tid_ >> 6), nw = nvb() * 4;
  const bf16_t* proj = (const bf16_t*)(p.ws + WS_PROJ);
  const bf16_t* RW = (const bf16_t*)(p.ws + WS_RW);
  const bf16_t* RG = (const bf16_t*)(p.ws + WS_RG);
  const float* RC = (const float*)(p.ws + WS_RC);
  bf16_t* Y = (bf16_t*)(p.ws + WS_Y);
  const int c = lane * 4;
  const float4 nw4 = *reinterpret_cast<const float4*>(p.in[13] + l * 256 + c);
  const float4 lw4 = *reinterpret_cast<const float4*>(p.in[23] + l * 256 + c);
  const float4 lb4 = *reinterpret_cast<const float4*>(p.in[24] + l * 256 + c);
  for (int row = gw; row < R; row += nw) {
    {
      const uint2 yr = *reinterpret_cast<const uint2*>(Y + (size_t)row * 1024 + c);
      const uint2 zr = *reinterpret_cast<const uint2*>(proj + (size_t)row * PJ + OFF_Z + c);
      const float y0 = lo2f(yr.x) * siluf_(lo2f(zr.x)), y1 = hi2f(yr.x) * siluf_(hi2f(zr.x));
      const float y2 = lo2f(yr.y) * siluf_(lo2f(zr.y)), y3 = hi2f(yr.y) * siluf_(hi2f(zr.y));
      float ss = y0 * y0 + y1 * y1 + y2 * y2 + y3 * y3;
#pragma unroll
      for (int o = 16; o >= 1; o >>= 1) ss += __shfl_xor(ss, o, 64);
      const float rs = rsqrtf(ss * (1.f / 128.f) + EPS);
      uint2 o;
      o.x = pack2(y0 * rs * nw4.x, y1 * rs * nw4.y);
      o.y = pack2(y2 * rs * nw4.z, y3 * rs * nw4.w);
      *reinterpret_cast<uint2*>(Y + (size_t)row * 1024 + c) = o;
    }
    {
      const uint2 yr = *reinterpret_cast<const uint2*>(Y + (size_t)row * 1024 + 768 + c);
      const uint2 gr = *reinterpret_cast<const uint2*>(proj + (size_t)row * PJ + OFF_RET + 512 + c);
      const float4 gw = *reinterpret_cast<const float4*>(p.in[32] + l * 256 + c);
      const float y0 = lo2f(yr.x), y1 = hi2f(yr.x), y2 = lo2f(yr.y), y3 = hi2f(yr.y);
      float sm = y0 + y1 + y2 + y3;
#pragma unroll
      for (int o = 8; o >= 1; o >>= 1) sm += __shfl_xor(sm, o, 64);
      const float mu = sm * (1.f / 64.f);
      const float d0 = y0 - mu, d1 = y1 - mu, d2 = y2 - mu, d3 = y3 - mu;
      float vs = d0 * d0 + d1 * d1 + d2 * d2 + d3 * d3;
#pragma unroll
      for (int o = 8; o >= 1; o >>= 1) vs += __shfl_xor(vs, o, 64);
      const float rs = rsqrtf(vs * (1.f / 64.f) + 1e-5f);
      uint2 o;
      o.x = pack2(d0 * rs * gw.x * siluf_(lo2f(gr.x)), d1 * rs * gw.y * siluf_(hi2f(gr.x)));
      o.y = pack2(d2 * rs * gw.z * siluf_(lo2f(gr.y)), d3 * rs * gw.w * siluf_(hi2f(gr.y)));
      *reinterpret_cast<uint2*>(Y + (size_t)row * 1024 + 768 + c) = o;
    }
    {
      const uint2 yr = *reinterpret_cast<const uint2*>(Y + (size_t)row * 1024 + 256 + c);
      const float y0 = lo2f(yr.x), y1 = hi2f(yr.x), y2 = lo2f(yr.y), y3 = hi2f(yr.y);
      float sm = y0 + y1 + y2 + y3;
#pragma unroll
      for (int o = 8; o >= 1; o >>= 1) sm += __shfl_xor(sm, o, 64);
      const float mu = sm * (1.f / 64.f);
      const float d0 = y0 - mu, d1 = y1 - mu, d2 = y2 - mu, d3 = y3 - mu;
      float vs = d0 * d0 + d1 * d1 + d2 * d2 + d3 * d3;
#pragma unroll
      for (int o = 8; o >= 1; o >>= 1) vs += __shfl_xor(vs, o, 64);
      const float rs = rsqrtf(vs * (1.f / 64.f) + 64e-5f);
      const float coef = RC[(size_t)row * 4 + (lane >> 4)];
      const uint2 vr = *reinterpret_cast<const uint2*>(RW + (size_t)row * 1536 + 1280 + c);
      const uint2 gr = *reinterpret_cast<const uint2*>(RG + (size_t)row * 256 + c);
      const float o0 = (d0 * rs * lw4.x + lb4.x + coef * lo2f(vr.x)) * lo2f(gr.x);
      const float o1 = (d1 * rs * lw4.y + lb4.y + coef * hi2f(vr.x)) * hi2f(gr.x);
      const float o2 = (d2 * rs * lw4.z + lb4.z + coef * lo2f(vr.y)) * lo2f(gr.y);
      const float o3 = (d3 * rs * lw4.w + lb4.w + coef * hi2f(vr.y)) * hi2f(gr.y);
      uint2 o;
      o.x = pack2(o0, o1);
      o.y = pack2(o2, o3);
      *reinterpret_cast<uint2*>(Y + (size_t)row * 1024 + 256 + c) = o;
    }
  }
}


#define XB_TMO      128
#define XB_XCNT(j)  (256  + 64 * (j))
#define XB_XSUB(j)  (1280 + 64 * (j))
#define XB_XGEN(j)  (2304 + 64 * (j))
#define XB_TOP      3328
#define XB_TOPGEN   3392
#define XCD_BAR_WORDS 3456
#define XB_SPIN_CAP (1u << 20)
#define LAS __attribute__((address_space(3)))
__device__ __forceinline__ unsigned xb_ld(unsigned* p) { return __hip_atomic_load(p, __ATOMIC_RELAXED, __HIP_MEMORY_SCOPE_AGENT); }
__device__ __forceinline__ unsigned xb_add(unsigned* p, unsigned v) { return __hip_atomic_fetch_add(p, v, __ATOMIC_RELAXED, __HIP_MEMORY_SCOPE_AGENT); }
__device__ __forceinline__ unsigned xb_xcc_id() { return (unsigned)__builtin_amdgcn_s_getreg((3 << 11) | 20) & 0xFu; }
#define XB_SPIN(cond, bar) do { unsigned _sp = 0; while (cond) { __builtin_amdgcn_s_sleep(1); \
    if ((++_sp & 255u) == 0u) { if (xb_ld(&(bar)[XB_TMO])) break; if (_sp > XB_SPIN_CAP) { atomicAdd(&(bar)[XB_TMO], 1u); break; } } } } while (0)
struct XcdBarrier { unsigned* bar; unsigned x; volatile LAS unsigned* st; };
__device__ __forceinline__ XcdBarrier xcd_barrier_post(unsigned* bar, volatile LAS unsigned* st) {
  XcdBarrier b; b.bar = bar; b.x = xb_xcc_id(); b.st = st;
  if (threadIdx.x == 0) (void)xb_add(&bar[XB_XCNT(b.x)], 1u);
  return b;
}
__device__ __forceinline__ void xcd_barrier_complete(unsigned* bar, unsigned x, unsigned& nloc, unsigned& nx) {
  const unsigned G = gridDim.x * gridDim.y * gridDim.z;
  unsigned sum, cnt, mine, sp = 0u;
  for (;;) {
    sum = 0u; cnt = 0u; mine = 0u;
#pragma unroll
    for (unsigned j = 0; j < 16; ++j) { const unsigned c = xb_ld(&bar[XB_XCNT(j)]); sum += c; cnt += (c > 0u) ? 1u : 0u; mine = (j == x) ? c : mine; }
    if (sum == G) break;
    __builtin_amdgcn_s_sleep(1);
    if ((++sp & 255u) == 0u) { if (xb_ld(&bar[XB_TMO])) break; if (sp > XB_SPIN_CAP) { atomicAdd(&bar[XB_TMO], 1u); break; } }
  }
  nloc = mine > 0u ? mine : 1u; nx = cnt > 0u ? cnt : 1u;
}
__device__ __forceinline__ void xcd_barrier(const XcdBarrier& b) {
  asm volatile("s_waitcnt vmcnt(0)" ::: "memory");
  __syncthreads();
  if (threadIdx.x == 0) {
    unsigned* bar = b.bar;
    __builtin_amdgcn_s_waitcnt(0);
    unsigned nloc = b.st[0], nx = b.st[1];
    if (nloc == 0u) { xcd_barrier_complete(bar, b.x, nloc, nx); b.st[0] = nloc; b.st[1] = nx; }
    const unsigned old = xb_add(&bar[XB_XSUB(b.x)], 1u);
    const unsigned gen = old / nloc;
    if (old + 1u == (gen + 1u) * nloc) {
      __builtin_amdgcn_fence(__ATOMIC_RELEASE, "agent");
      asm volatile("s_waitcnt vmcnt(0)" ::: "memory");
      const unsigned og = xb_add(&bar[XB_TOP], 1u);
      const unsigned tg = og / nx;
      if (og + 1u == (tg + 1u) * nx) xb_add(&bar[XB_TOPGEN], 1u);
      else XB_SPIN(xb_ld(&bar[XB_TOPGEN]) == tg, bar);
      __builtin_amdgcn_fence(__ATOMIC_ACQUIRE, "agent");
      xb_add(&bar[XB_XGEN(b.x)], 1u);
      asm volatile("s_waitcnt vmcnt(0)" ::: "memory");
    } else {
      XB_SPIN(xb_ld(&bar[XB_XGEN(b.x)]) == gen, bar);
      __builtin_amdgcn_fence(__ATOMIC_ACQUIRE, "agent");
      asm volatile("s_waitcnt vmcnt(0)" ::: "memory");
    }
  }
  __syncthreads();
}

constexpr int NPH = NL * 9 + 1;
#ifndef SCAN_REP
#define SCAN_REP 0
#endif
#ifndef PH_MASK
#define PH_MASK 0x3ff
#endif

__device__ __forceinline__ void run_phase(CP p, int ph, char* smem_full) {
  const int l = ph / 9, s = ph % 9;
  const int vb = bidx(), NVB = nvb();
  char* smem = smem_full + half_id() * 65536;
  bf16_t* WA = (bf16_t*)(p.ws + WS_WA);
  bf16_t* WB = (bf16_t*)(p.ws + WS_WB);
  bf16_t* WO = (bf16_t*)(p.ws + WS_WO);
  bf16_t* PROJ = (bf16_t*)(p.ws + WS_PROJ);
  bf16_t* Yb = (bf16_t*)(p.ws + WS_Y);
  float* TMP = (float*)(p.ws + WS_TMP);
  if (ph == NPH - 1) {
    rowwise_phase(p, 1, p.in[5] + (NL - 1) * D, nullptr, false, DFF / 256);
    return;
  }
  if (!((PH_MASK >> s) & 1)) return;
  switch (s) {
    case 0: {
      if (l == 0) {
        float2* rope = (float2*)(p.ws + WS_ROPE);
        for (int i = vb * 256 + tidx(); i < T * 16; i += NVB * 256) {
          const int t = i >> 4, f = i & 15;
          const float freq = powf(10000.f, -(float)f / 16.f);
          const float ang = (float)t * freq;
          rope[i] = make_float2(cosf(ang), sinf(ang));
        }
        rowwise_phase(p, 0, nullptr, p.in[2], true, 0);
      } else {
        rowwise_phase(p, 1, p.in[5] + (l - 1) * D, p.in[2] + l * D, true, DFF / 256);
      }
      conv_matrix(p.in[6] + (size_t)l * D * MIXIN, WA, D, MIXIN, NIN_PAD, 0, smem, vb, NVB);
      for (int id = NVB - 1 - vb; id < 24; id += NVB) {
        if (id < 4) conv_tile(p.in[16] + (size_t)l * 64 * 256, (bf16_t*)(p.ws + WS_W2T), 64, 256, 0, id * 64, 0, smem);
        else if (id < 8) conv_tile(p.in[18] + (size_t)l * 64 * 256, (bf16_t*)(p.ws + WS_A2T), 64, 256, 0, (id - 4) * 64, 0, smem);
        else if (id < 16) conv_tile(p.in[19] + (size_t)l * 128 * 256, (bf16_t*)(p.ws + WS_G2T), 128, 256, ((id - 8) & 1) * 64, ((id - 8) >> 1) * 64, 0, smem);
        else if (id < 20) conv_tile(p.in[27] + (size_t)l * 16384 + (size_t)(id - 16) * 4096, (bf16_t*)(p.ws + WS_WAT) + (id - 16) * 4096, 64, 64, 0, 0, 0, smem);
        else conv_tile(p.in[29] + (size_t)l * 16384 + (size_t)(id - 20) * 4096, (bf16_t*)(p.ws + WS_WXT) + (id - 20) * 4096, 64, 64, 0, 0, 0, smem);
      }
    } break;
    case 1: gemm_phase256<EPI_BF16>(Yb, WA, D, 14, smem_full, PROJ, PJ, MIXIN); break;
    case 2: {
      for (int u = vb; u < NB * 129; u += NVB) prep_unit(p, l, u, smem);
    } break;
    case 3: {
      for (int u = vb; u < 320; u += NVB) {
        if (u < 128) { for (int rr_ = 0; rr_ < ((SCAN_REP >> 0) & 1) + 1; ++rr_) rwkv_scan_unit(p, u, smem); }
        else if (u < 256) { for (int rr_ = 0; rr_ < ((SCAN_REP >> 1) & 1) + 1; ++rr_) ssd_scan_unit(p, l, u - 128, smem); }
        else if (u < 272) ret_mfma_unit(p, l, u - 256, smem);
        else if (u < 288) { }
        else if (u < 320) { for (int rr_ = 0; rr_ < ((SCAN_REP >> 3) & 1) + 1; ++rr_) lru_scan_unit(p, u - 288, smem); }
      }
      {
        const int nwork = NVB > 320 ? NVB - 320 : NVB;
        const int wk = NVB > 320 ? vb - 320 : vb;
        const int ngu = 16 * 44;
        if (wk >= 0) {
          for (int id = wk; id < 256 + 2 * ngu + 44 * 16; id += nwork) {
            if (id < 256) conv_tile(p.in[7] + (size_t)l * D * D, WO, D, D, (id % 16) * 64, (id / 16) * 64, 0, smem);
            else if (id < 256 + ngu) { const int k = id - 256; conv_tile(p.in[33] + (size_t)l * D * DFF, WA, D, DFF, (k % 16) * 64, (k / 16) * 64, 1, smem); }
            else if (id < 256 + 2 * ngu) { const int k = id - 256 - ngu; conv_tile(p.in[34] + (size_t)l * D * DFF, WA, D, DFF, (k % 16) * 64, (k / 16) * 64, 2, smem); }
            else { const int k = id - 256 - 2 * ngu; conv_tile(p.in[35] + (size_t)l * DFF * D, WB, DFF, D, (k % 44) * 64, (k / 44) * 64, 0, smem); }
          }
        }
      }
    } break;
    case 4: epi_phase(p, l); break;
    case 5: gemm_phase_n1024<D>(p, Yb, WO, smem_full, TMP); break;
    case 8: gemm_phase_n1024<DFF>(p, PROJ, WB, smem_full, TMP); break;
    case 6: rowwise_phase(p, 1, p.in[3] + l * D, p.in[4] + l * D, true, D / 256); break;
    case 7: gemm_phase256<EPI_GLU>(Yb, WA, D, 22, smem_full, PROJ, DFF, DFF); break;
  }
}

#ifndef SCAN_REP
#define SCAN_REP 0
#endif
#ifndef REPEAT_MASK
#define REPEAT_MASK 0
#endif
__global__ void __launch_bounds__(512) hybrid_trunk_kernel(Params p, int ph_lo, int ph_hi) {
  __shared__ __attribute__((aligned(16))) char smem[131072 + 16];
  cg::grid_group grid = cg::this_grid();
#if MULTI_LAUNCH
  for (int ph = ph_lo; ph < ph_hi; ++ph) {
    run_phase(*(const __attribute__((address_space(4))) Params*)__builtin_amdgcn_kernarg_segment_ptr(), ph, smem);
    if (ph + 1 < ph_hi) grid.sync();
  }
#else
  volatile LAS unsigned* stw = (volatile LAS unsigned*)(smem + 131072);
  if (threadIdx.x < 4) stw[threadIdx.x] = 0u;
  __syncthreads();
  XcdBarrier xb = xcd_barrier_post((unsigned*)(p.ws + WS_BAR), stw);
  if (ph_hi < 0) grid.sync();
  for (int ph = ph_lo; ph < ph_hi; ++ph) {
    const int nrep = (REPEAT_MASK != 0 && ph < NPH - 1 && ((REPEAT_MASK >> (ph % 9)) & 1)) ? 2 : 1;
    for (int r = 0; r < nrep; ++r) {
      {
        const __attribute__((address_space(4))) Params* pp = (const __attribute__((address_space(4))) Params*)__builtin_amdgcn_kernarg_segment_ptr();
        asm volatile("" : "+s"(pp));
        run_phase(*pp, ph, smem);
      }
      if (r + 1 < nrep || ph + 1 < ph_hi) xcd_barrier(xb);
    }
  }
#endif
}

extern "C" void kernel_launch(void* const* d_in, const int* in_sizes, int n_in, void* d_out, int out_size, void* d_ws,
                              size_t ws_size, hipStream_t stream) {
  static int grid_blocks = 0;
  if (!grid_blocks) {
    int dev = 0, cus = 0, per_cu = 0;
    hipGetDevice(&dev);
    hipDeviceGetAttribute(&cus, hipDeviceAttributeMultiprocessorCount, dev);
    hipOccupancyMaxActiveBlocksPerMultiprocessor(&per_cu, hybrid_trunk_kernel, 512, 0);
    if (per_cu > 1) per_cu = 1;
    if (per_cu < 1) per_cu = 1;
    grid_blocks = cus * per_cu;
  }
  if (ws_size < WS_TOTAL || n_in < 36) {
    fprintf(stderr, "workspace too small: %zu < %zu\n", ws_size, (size_t)WS_END);
    return;
  }
  Params p{};
  for (int i = 0; i < 36; ++i) p.in[i] = (const float*)d_in[i];
  p.out = (float*)d_out;
  p.ws = (char*)d_ws;
#if MULTI_LAUNCH
  for (int ph = 0; ph < NPH; ++ph) {
    hipLaunchKernelGGL(hybrid_trunk_kernel, dim3(grid_blocks), dim3(512), 0, stream, p, ph, ph + 1);
  }
#else
  hipMemsetAsync((char*)d_ws + WS_BAR, 0, XCD_BAR_WORDS * 4, stream);
  int lo = 0, hi = NPH;
  void* args[] = {&p, &lo, &hi};
  hipError_t e = hipLaunchCooperativeKernel((void*)hybrid_trunk_kernel, dim3(grid_blocks), dim3(512), args, 0, stream);
  if (e != hipSuccess) fprintf(stderr, "cooperative launch failed: %s (grid %d)\n", hipGetErrorString(e), grid_blocks);
#endif
}
```

```cpp
#include <hip/hip_runtime.h>
#include <hip/hip_bf16.h>
#include <hip/hip_cooperative_groups.h>
#include <cstdio>
#include <cstdint>
namespace cg = cooperative_groups;

#ifndef MULTI_LAUNCH
#define MULTI_LAUNCH 0
#endif

typedef unsigned short bf16_t;
using bf16x8 = __attribute__((ext_vector_type(8))) short;
using f32x4 = __attribute__((ext_vector_type(4))) float;

constexpr int D = 1024, NB = 8, SEQ = 2048, NMETA = 16, T = 2064, R = NB * T, NL = 4;
constexpr int RREAL = NB * SEQ;
constexpr int MIXIN = 3332, PJ = 3336, NIN_PAD = 3456, DFF = 2816;
constexpr int OFF_Z = 0, OFF_XBC = 256, OFF_DT = 1024, OFF_RW = 1028, OFF_LRU = 2052, OFF_RET = 2564;
constexpr float EPS = 1e-6f;

constexpr size_t WS_BAR = 0;
constexpr size_t WS_HMETA = 16384;
constexpr size_t WS_ROPE = WS_HMETA + 128 * 1024 * 4;
constexpr size_t WS_WA = 1048576;
constexpr size_t WS_WB = WS_WA + (size_t)5632 * 1024 * 2;
constexpr size_t WS_PROJ = WS_WB + (size_t)1024 * 2816 * 2;
constexpr size_t WS_Y = WS_PROJ + (size_t)R * PJ * 2;
constexpr size_t WS_SCR = WS_Y + (size_t)R * 1024 * 2;
constexpr size_t WS_RW = WS_SCR;
constexpr size_t WS_SS = WS_RW + (size_t)R * 1536 * 2;
constexpr size_t WS_LR = WS_SS + (size_t)R * 768 * 2;
constexpr size_t WS_RG = WS_LR + (size_t)R * 512 * 2;
constexpr size_t WS_RC = WS_RG + (size_t)R * 256 * 2;
constexpr size_t WS_SD = WS_RC + (size_t)R * 4 * 4;
constexpr size_t WS_END = WS_SD + (size_t)R * 4 * 4;
constexpr size_t WS_WO = WS_END;
constexpr size_t WS_TOTAL = WS_WO + (size_t)1024 * 1024 * 2;
constexpr size_t WS_TMP = WS_SCR;
static_assert((size_t)R * 1024 * 4 <= WS_END - WS_SCR, "tmp must fit in scratch");

struct Params {
  const float* in[36];
  float* out;
  char* ws;
};
typedef const __attribute__((address_space(4))) Params& CP;

__device__ __forceinline__ float bf2f(bf16_t v) { return __uint_as_float(((unsigned)v) << 16); }
typedef __bf16 hwbf16x2 __attribute__((ext_vector_type(2)));
typedef float hwf32x2 __attribute__((ext_vector_type(2)));
__device__ __forceinline__ unsigned pack2(float a, float b) {
  const hwf32x2 v = {a, b};
  const hwbf16x2 r = __builtin_convertvector(v, hwbf16x2);
  return __builtin_bit_cast(unsigned, r);
}
__device__ __forceinline__ bf16_t f2bf(float f) { return (bf16_t)(pack2(f, 0.f) & 0xffffu); }
__device__ __forceinline__ float lo2f(unsigned w) { return __uint_as_float(w << 16); }
__device__ __forceinline__ float hi2f(unsigned w) { return __uint_as_float(w & 0xffff0000u); }
__device__ __forceinline__ float sigmoidf_(float x) { return __builtin_amdgcn_rcpf(1.f + __expf(-x)); }
__device__ __forceinline__ float softplusf_(float x) { return fmaxf(x, 0.f) + log1pf(__expf(-fabsf(x))); }
__device__ __forceinline__ float siluf_(float x) { return x * __builtin_amdgcn_rcpf(1.f + __expf(-x)); }
__device__ __forceinline__ float wave_sum(float v) {
#pragma unroll
  for (int o = 32; o >= 1; o >>= 1) v += __shfl_xor(v, o, 64);
  return v;
}
__device__ __forceinline__ int tidx() { int t = threadIdx.x & 255; asm volatile("" : "+v"(t)); return t; }
__device__ __forceinline__ int tidx_full() { int t = threadIdx.x; asm volatile("" : "+v"(t)); return t; }
__device__ __forceinline__ int half_id() { int t = (int)(threadIdx.x >> 8); asm volatile("" : "+v"(t)); return __builtin_amdgcn_readfirstlane(t); }
__device__ __forceinline__ int bidx() { int t = blockIdx.x + half_id() * gridDim.x; asm volatile("" : "+s"(t)); return t; }
__device__ __forceinline__ int nvb() { return gridDim.x * 2; }
#define LAS3 __attribute__((address_space(3)))
__device__ __forceinline__ void half_barrier(char* smem_half) {
  const int h = half_id();
  LAS3 unsigned* cnt = (LAS3 unsigned*)(smem_half + (2 - h) * 65536 + 8 + h * 4);
  asm volatile("s_waitcnt lgkmcnt(0)" ::: "memory");
  if ((tidx() & 63) == 0) {
    const unsigned old = __hip_atomic_fetch_add(cnt, 1u, __ATOMIC_RELAXED, __HIP_MEMORY_SCOPE_WORKGROUP);
    const unsigned target = (old & ~3u) + 4u;
    while (__hip_atomic_load(cnt, __ATOMIC_RELAXED, __HIP_MEMORY_SCOPE_WORKGROUP) < target) __builtin_amdgcn_s_sleep(1);
  }
  asm volatile("" ::: "memory");
}
template <int CTRL>
__device__ __forceinline__ float dppf(float x) {
  return __int_as_float(__builtin_amdgcn_update_dpp(0, __float_as_int(x), CTRL, 0xF, 0xF, true));
}
__device__ __forceinline__ float allreduce4(float x) {
  x += dppf<0xB1>(x);
  x += dppf<0x4E>(x);
  return x;
}
__device__ __forceinline__ float allreduce16(float x) {
  x += dppf<0xB1>(x);
  x += dppf<0x4E>(x);
  x += dppf<0x141>(x);
  x += dppf<0x140>(x);
  return x;
}
__device__ __forceinline__ int rowof(int b, int t) { return t < NMETA ? RREAL + b * NMETA + t : b * SEQ + t - NMETA; }
__device__ __forceinline__ float* hrow_ptr(CP p, int row) {
  return row < RREAL ? p.out + (size_t)row * D : (float*)(p.ws + WS_HMETA) + (size_t)(row - RREAL) * D;
}

__device__ __forceinline__ int lds_byte(int r, int c) {
  int st = (r >> 4) * 2 + (c >> 5), rr = r & 15, cc = c & 31, ob = rr * 64 + cc * 2;
  return st * 1024 + (ob ^ (((ob >> 9) & 1) << 5));
}
__device__ __forceinline__ void stage_rc(int b, int& Rr, int& Cc) {
  int st = b / 1024, sb = b % 1024, swz = sb ^ (((sb >> 9) & 1) << 5);
  Rr = (st >> 1) * 16 + swz / 64;
  Cc = (st & 1) * 32 + (swz % 64) / 2;
}
typedef __attribute__((address_space(3))) unsigned lds_u32;
typedef __attribute__((address_space(1))) const unsigned glb_u32;

enum { EPI_BF16 = 0, EPI_F32 = 1, EPI_GLU = 2, EPI_PART = 3 };

template <int EPI>
__device__ __forceinline__ void gemm_tile256(const bf16_t* __restrict__ A, const bf16_t* __restrict__ Bt, int K, int nk, int brow, int bcol,
                             char* smem, void* outp, int ldo, int nvalid) {
  const int tid = tidx_full(), wid = tid >> 6, lane = tid & 63, wr = wid >> 2, wc = wid & 3, fr = lane & 15, fq = lane >> 4;
  f32x4 acc[8][4];
#pragma unroll
  for (int m = 0; m < 8; ++m)
#pragma unroll
    for (int n = 0; n < 4; ++n) acc[m][n] = f32x4{0.f, 0.f, 0.f, 0.f};
  const bf16_t* Ab = A + (size_t)brow * K;
  const bf16_t* Bb = Bt + (size_t)bcol * K;
  int soff[4];
#pragma unroll
  for (int i = 0; i < 4; ++i) {
    int r, c;
    stage_rc(tid * 16 + i * 8192, r, c);
    soff[i] = r * K + c;
  }
  auto stage = [&](int buf, int kt) {
    char* sa = smem + buf * 65536;
    char* sb = sa + 32768;
#pragma unroll
    for (int i = 0; i < 4; ++i) {
      const int b = tid * 16 + i * 8192;
      __builtin_amdgcn_global_load_lds((glb_u32*)(Ab + soff[i] + kt * 64), (lds_u32*)(sa + b), 16, 0, 0);
      __builtin_amdgcn_global_load_lds((glb_u32*)(Bb + soff[i] + kt * 64), (lds_u32*)(sb + b), 16, 0, 0);
    }
  };
  stage(0, 0);
  for (int kt = 0; kt < nk; ++kt) {
    asm volatile("s_waitcnt vmcnt(0)" ::: "memory");
    __syncthreads();
    if (kt + 1 < nk) stage((kt + 1) & 1, kt + 1);
    const char* sa = smem + (kt & 1) * 65536;
    const char* sb = sa + 32768;
#pragma unroll
    for (int k = 0; k < 2; ++k) {
      bf16x8 af[8], bfr[4];
#pragma unroll
      for (int m = 0; m < 8; ++m) af[m] = *reinterpret_cast<const bf16x8*>(sa + lds_byte(wr * 128 + m * 16 + fr, k * 32 + fq * 8));
#pragma unroll
      for (int n = 0; n < 4; ++n) bfr[n] = *reinterpret_cast<const bf16x8*>(sb + lds_byte(wc * 64 + n * 16 + fr, k * 32 + fq * 8));
      __builtin_amdgcn_sched_barrier(0);
#pragma unroll
      for (int m = 0; m < 8; ++m)
#pragma unroll
        for (int n = 0; n < 4; ++n) acc[m][n] = __builtin_amdgcn_mfma_f32_16x16x32_bf16(bfr[n], af[m], acc[m][n], 0, 0, 0);
      __builtin_amdgcn_sched_barrier(0);
    }
  }
  __syncthreads();
  if (EPI == EPI_BF16) {
    bf16_t* O = (bf16_t*)outp;
#pragma unroll
    for (int m = 0; m < 8; ++m) {
      const int row = brow + wr * 128 + m * 16 + fr;
#pragma unroll
      for (int n = 0; n < 4; ++n) {
        const int col = bcol + wc * 64 + n * 16 + fq * 4;
        if (col < nvalid && row < R)
          *reinterpret_cast<uint2*>(O + (size_t)row * ldo + col) = make_uint2(pack2(acc[m][n][0], acc[m][n][1]), pack2(acc[m][n][2], acc[m][n][3]));
      }
    }
  } else if (EPI == EPI_F32) {
    float* O = (float*)outp;
#pragma unroll
    for (int m = 0; m < 8; ++m) {
      const int row = brow + wr * 128 + m * 16 + fr;
#pragma unroll
      for (int n = 0; n < 4; ++n) {
        const int col = bcol + wc * 64 + n * 16 + fq * 4;
        if (row < R) *reinterpret_cast<float4*>(O + (size_t)row * ldo + col) = make_float4(acc[m][n][0], acc[m][n][1], acc[m][n][2], acc[m][n][3]);
      }
    }
  } else if (EPI == EPI_PART) {
    float* O = (float*)outp;
    if (wr == 0) {
#pragma unroll
      for (int m = 0; m < 8; ++m)
#pragma unroll
        for (int n = 0; n < 4; ++n) {
          const int col = bcol + wc * 64 + n * 16 + fq * 4;
          *reinterpret_cast<float4*>(O + (size_t)(m * 16 + fr) * ldo + col) = make_float4(acc[m][n][0], acc[m][n][1], acc[m][n][2], acc[m][n][3]);
        }
    }
  } else {
    bf16_t* O = (bf16_t*)outp;
#pragma unroll
    for (int m = 0; m < 8; ++m) {
      const int row = brow + wr * 128 + m * 16 + fr;
#pragma unroll
      for (int n = 0; n < 2; ++n) {
        const int col = (bcol >> 8) * 128 + wc * 32 + n * 16 + fq * 4;
        float a[4];
#pragma unroll
        for (int j = 0; j < 4; ++j) a[j] = siluf_(acc[m][n][j]) * acc[m][n + 2][j];
        if (row < R) *reinterpret_cast<uint2*>(O + (size_t)row * ldo + col) = make_uint2(pack2(a[0], a[1]), pack2(a[2], a[3]));
      }
    }
  }
}

template <int EPI>
__device__ __forceinline__ void gemm_tile8p(const bf16_t* __restrict__ Ag, const bf16_t* __restrict__ Bg, int K, int nt, int brow, int bcol,
                                            char* smem, void* outp, int ldo, int nvalid, int rowoff, int rowlim) {
  constexpr int HT = 128 * 64, HALF = 128;
  bf16_t* shm = (bf16_t*)smem;
  const int tid = tidx_full();
  const int wid = tid >> 6, lane = tid & 63, wr = wid >> 2, wc = wid & 3, fr = lane & 15, fq = lane >> 4;
  int goff0;
  { int r, c; stage_rc(tid * 16, r, c); goff0 = r * K + c; }
#define SA8(b, h) (shm + ((b) * 2 + (h)) * HT)
#define SB8(b, h) (shm + (4 + (b) * 2 + (h)) * HT)
#define STAGE8(P, BASE, br, kt) do { const bf16_t* _g = (BASE) + (size_t)(br) * K + (kt) * 64; \
    _Pragma("unroll") for (int _i = 0; _i < 2; ++_i) \
      __builtin_amdgcn_global_load_lds((glb_u32*)(_g + goff0 + _i * 64 * K), (lds_u32*)((char*)(P) + tid * 16 + _i * 8192), 16, 0, 0); } while (0)
#define LDA8(dst, b, h) _Pragma("unroll") for (int m = 0; m < 4; ++m) _Pragma("unroll") for (int k = 0; k < 2; ++k) \
    dst[m][k] = *reinterpret_cast<const bf16x8*>((const char*)SA8(b, h) + lds_byte(wr * 64 + m * 16 + fr, k * 32 + fq * 8))
#define LDB8(dst, b, h) _Pragma("unroll") for (int n = 0; n < 2; ++n) _Pragma("unroll") for (int k = 0; k < 2; ++k) \
    dst[n][k] = *reinterpret_cast<const bf16x8*>((const char*)SB8(b, h) + lds_byte(wc * 32 + n * 16 + fr, k * 32 + fq * 8))
#define MMA8(ai, bj, Af, Bf) do { __builtin_amdgcn_s_setprio(3); \
    _Pragma("unroll") for (int m = 0; m < 4; ++m) _Pragma("unroll") for (int n = 0; n < 2; ++n) _Pragma("unroll") for (int k = 0; k < 2; ++k) \
      acc[ai][bj][m][n] = __builtin_amdgcn_mfma_f32_16x16x32_bf16(Af[m][k], Bf[n][k], acc[ai][bj][m][n], 0, 0, 0); \
    __builtin_amdgcn_s_setprio(0); } while (0)
#define WAIT_V8(n) asm volatile("s_waitcnt vmcnt(" #n ")" ::: "memory")
#define WAIT_L8(n) asm volatile("s_waitcnt lgkmcnt(" #n ")" ::: "memory")
#define BAR8 __builtin_amdgcn_s_barrier()
#define SCHED8 __builtin_amdgcn_sched_barrier(0)
  f32x4 acc[2][2][4][2];
#pragma unroll
  for (int a = 0; a < 2; ++a)
#pragma unroll
    for (int b = 0; b < 2; ++b)
#pragma unroll
      for (int m = 0; m < 4; ++m)
#pragma unroll
        for (int n = 0; n < 2; ++n) acc[a][b][m][n] = f32x4{0.f, 0.f, 0.f, 0.f};
  bf16x8 At[4][2], B0[2][2], B1[2][2];
  STAGE8(SB8(0, 0), Bg, bcol, 0); STAGE8(SA8(0, 0), Ag, brow, 0);
  STAGE8(SB8(0, 1), Bg, bcol + HALF, 0); STAGE8(SA8(0, 1), Ag, brow + HALF, 0);
  if (wr == 1) BAR8;
  WAIT_V8(4); BAR8;
  STAGE8(SB8(1, 0), Bg, bcol, 1); STAGE8(SA8(1, 0), Ag, brow, 1); STAGE8(SB8(1, 1), Bg, bcol + HALF, 1);
  WAIT_V8(6); BAR8;
  for (int t = 0; t < nt - 2; t += 2) {
    LDB8(B0, 0, 0); SCHED8; LDA8(At, 0, 0); STAGE8(SA8(1, 1), Ag, brow + HALF, t + 1);
    WAIT_L8(8); BAR8; WAIT_L8(0); MMA8(0, 0, At, B0); BAR8; SCHED8;
    LDB8(B1, 0, 1); STAGE8(SB8(0, 0), Bg, bcol, t + 2);
    BAR8; WAIT_L8(0); MMA8(0, 1, At, B1); BAR8;
    LDA8(At, 0, 1); STAGE8(SA8(0, 0), Ag, brow, t + 2);
    BAR8; WAIT_L8(0); MMA8(1, 0, At, B0); BAR8; SCHED8;
    STAGE8(SB8(0, 1), Bg, bcol + HALF, t + 2);
    WAIT_V8(6); BAR8; MMA8(1, 1, At, B1); BAR8;
    LDB8(B0, 1, 0); SCHED8; LDA8(At, 1, 0); STAGE8(SA8(0, 1), Ag, brow + HALF, t + 2);
    WAIT_L8(8); BAR8; WAIT_L8(0); MMA8(0, 0, At, B0); BAR8; SCHED8;
    LDB8(B1, 1, 1); STAGE8(SB8(1, 0), Bg, bcol, t + 3);
    BAR8; WAIT_L8(0); MMA8(0, 1, At, B1); BAR8;
    LDA8(At, 1, 1); STAGE8(SA8(1, 0), Ag, brow, t + 3);
    BAR8; WAIT_L8(0); MMA8(1, 0, At, B0); BAR8; SCHED8;
    STAGE8(SB8(1, 1), Bg, bcol + HALF, t + 3);
    WAIT_V8(6); BAR8; MMA8(1, 1, At, B1); BAR8;
  }
  { LDB8(B0, 0, 0); LDA8(At, 0, 0); STAGE8(SA8(1, 1), Ag, brow + HALF, nt - 1);
    BAR8; WAIT_L8(0); MMA8(0, 0, At, B0); BAR8;
    LDB8(B1, 0, 1); BAR8; WAIT_L8(0); MMA8(0, 1, At, B1); BAR8;
    LDA8(At, 0, 1); WAIT_V8(4); BAR8; WAIT_L8(0); MMA8(1, 0, At, B0); MMA8(1, 1, At, B1); BAR8; }
  { LDB8(B0, 1, 0); LDA8(At, 1, 0); WAIT_V8(2); BAR8; WAIT_L8(0); MMA8(0, 0, At, B0); BAR8;
    LDB8(B1, 1, 1); WAIT_V8(0); BAR8; WAIT_L8(0); MMA8(0, 1, At, B1); BAR8;
    LDA8(At, 1, 1); BAR8; WAIT_L8(0); MMA8(1, 0, At, B0); MMA8(1, 1, At, B1); BAR8; }
  if (wr == 0) BAR8;
#pragma unroll
  for (int ai = 0; ai < 2; ++ai)
#pragma unroll
    for (int m = 0; m < 4; ++m)
#pragma unroll
      for (int j = 0; j < 4; ++j) {
        const int rl = ai * HALF + wr * 64 + m * 16 + fq * 4 + j;
        const size_t orow = (size_t)(rowoff + rl) * ldo;
        if (EPI == EPI_GLU) {
#pragma unroll
          for (int n = 0; n < 2; ++n) {
            const int col = (bcol >> 8) * 128 + wc * 32 + n * 16 + fr;
            const float g = acc[ai][0][m][n][j], u = acc[ai][1][m][n][j];
            if (rl < rowlim) ((bf16_t*)outp)[orow + col] = f2bf(siluf_(g) * u);
          }
        } else {
#pragma unroll
          for (int bj = 0; bj < 2; ++bj)
#pragma unroll
            for (int n = 0; n < 2; ++n) {
              const int col = bcol + bj * HALF + wc * 32 + n * 16 + fr;
              const float v = acc[ai][bj][m][n][j];
              if (EPI == EPI_BF16) { if (rl < rowlim && col < nvalid) ((bf16_t*)outp)[orow + col] = f2bf(v); }
              else { if (rl < rowlim) ((float*)outp)[orow + col] = v; }
            }
        }
        __builtin_amdgcn_sched_barrier(0);
      }
#undef SA8
#undef SB8
#undef STAGE8
#undef LDA8
#undef LDB8
#undef MMA8
#undef WAIT_V8
#undef WAIT_L8
#undef BAR8
#undef SCHED8
  __syncthreads();
}

template <int EPI>
__device__ __forceinline__ void gemm_phase256(const bf16_t* A, const bf16_t* Bt, int K, int NT, char* smem, void* outp, int ldo, int nvalid) {
  constexpr int TM = (R + 255) / 256;
  const int ntiles = TM * NT;
  const int nb = gridDim.x;
  const int xcd = blockIdx.x & 7, slot = blockIdx.x >> 3, per = nb >> 3;
  for (int it = 0; it * nb < ntiles; ++it) {
    const int k = (it * 8 + xcd) * per + slot;
    if (k >= ntiles) continue;
    const int panel = k / (TM * 8);
    const int w = min(8, NT - panel * 8);
    const int idx = k - panel * TM * 8;
    const int tm = idx / w, tn = panel * 8 + idx % w;
    gemm_tile8p<EPI>(A, Bt, K, K >> 6, tm * 256, tn * 256, smem, outp, ldo, nvalid, tm * 256, R - tm * 256);
  }
}

constexpr size_t WS_PART = WS_TMP + (size_t)68 * 1024 * 1024;
static_assert(WS_PART + (size_t)11 * 128 * 1024 * 4 <= WS_END, "partial slabs must fit");
template <int K>
__device__ __forceinline__ void gemm_phase_n1024(CP p, const bf16_t* A, const bf16_t* Bt, char* smem, float* outp) {
  const int nb = gridDim.x;
  const int xcd = blockIdx.x & 7, slot = blockIdx.x >> 3, per = nb >> 3;
  const int nkc = K >> 8;
  const int nmain = 256, nitems = nmain + 4 * nkc;
  float* part = (float*)(p.ws + WS_PART);
  for (int it = 0; it * nb < nitems; ++it) {
    int id = it * nb + blockIdx.x;
    if ((it + 1) * nb <= nmain) id = (it * 8 + xcd) * per + slot;
    if (id >= nitems) break;
    const bf16_t* Ai = A; const bf16_t* Bi = Bt; float* Oi = outp;
    int nti = K >> 6, brow = (id >> 2) * 256, bcol = (id & 3) * 256, rowoff = brow, rowlim = 256;
    if (id >= nmain) {
      const int pid = id - nmain, kc = pid >> 2;
      Ai = A + kc * 256; Bi = Bt + kc * 256; Oi = part + (size_t)kc * 128 * 1024;
      nti = 4; brow = RREAL; bcol = (pid & 3) * 256; rowoff = 0; rowlim = 128;
    }
    gemm_tile8p<EPI_F32>(Ai, Bi, K, nti, brow, bcol, smem, Oi, D, D, rowoff, rowlim);
  }
}

__device__ __forceinline__ int map_n(int n, int maptype) {
  if (maptype == 0) return n;
  return (n >> 7) * 256 + (n & 127) + (maptype == 2 ? 128 : 0);
}
__device__ __forceinline__ void conv_tile(const float* __restrict__ src, bf16_t* __restrict__ dst, int K, int N, int k0, int n0, int maptype,
                          char* smem) {
  bf16_t* tile = (bf16_t*)smem;
  const int tid = tidx();
  half_barrier(smem);
#pragma unroll
  for (int i = 0; i < 4; ++i) {
    const int idx = tid + i * 256, k = idx >> 4, c4 = idx & 15, n = n0 + c4 * 4;
    float4 v = make_float4(0.f, 0.f, 0.f, 0.f);
    if (n < N) {
      const float* sp_ = src + (size_t)(k0 + k) * N + n;
      v = make_float4(__builtin_nontemporal_load(sp_), __builtin_nontemporal_load(sp_ + 1), __builtin_nontemporal_load(sp_ + 2), __builtin_nontemporal_load(sp_ + 3));
    }
    tile[(c4 * 4 + 0) * 72 + k] = f2bf(v.x);
    tile[(c4 * 4 + 1) * 72 + k] = f2bf(v.y);
    tile[(c4 * 4 + 2) * 72 + k] = f2bf(v.z);
    tile[(c4 * 4 + 3) * 72 + k] = f2bf(v.w);
  }
  half_barrier(smem);
#pragma unroll
  for (int i = 0; i < 2; ++i) {
    const int idx = tid + i * 256, n = idx >> 3, kc = idx & 7;
    uint4 v = *reinterpret_cast<const uint4*>(tile + n * 72 + kc * 8);
    *reinterpret_cast<uint4*>(dst + (size_t)map_n(n0 + n, maptype) * K + k0 + kc * 8) = v;
  }
}
__device__ __forceinline__ void conv_matrix(const float* src, bf16_t* dst, int K, int N, int Npad, int maptype, char* smem, int start, int stride) {
  const int nkt = K / 64, nnt = Npad / 64;
  for (int id = start; id < nkt * nnt; id += stride) conv_tile(src, dst, K, N, (id % nkt) * 64, (id / nkt) * 64, maptype, smem);
}

__device__ __forceinline__ void rowwise_phase(CP p, int mode, const float* wpost, const float* wpre, bool write_hn, int nparts) {
  const int tid_ = tidx(); const int lane = tid_ & 63, gw = bidx() * 4 + (tid_ >> 6), nw = nvb() * 4;
  const float* tmp = (const float*)(p.ws + WS_TMP);
  bf16_t* hn = (bf16_t*)(p.ws + WS_Y);
  float4 wpo[4], wpr[4];
#pragma unroll
  for (int q = 0; q < 4; ++q) {
    wpo[q] = (mode != 0) ? *reinterpret_cast<const float4*>(wpost + q * 256 + lane * 4) : make_float4(0.f, 0.f, 0.f, 0.f);
    wpr[q] = write_hn ? *reinterpret_cast<const float4*>(wpre + q * 256 + lane * 4) : make_float4(0.f, 0.f, 0.f, 0.f);
  }
  float4 tv[4], hv[4], tvn[4], hvn[4], tvm[4], hvm[4];
  auto loadrow = [&](int row, float4 (&t)[4], float4 (&h)[4]) {
    if (mode == 0) {
      const float* src = row < RREAL ? p.in[0] + (size_t)row * D : p.in[1] + (size_t)((row - RREAL) & 15) * D;
#pragma unroll
      for (int q = 0; q < 4; ++q) { h[q] = *reinterpret_cast<const float4*>(src + q * 256 + lane * 4); t[q] = make_float4(0.f, 0.f, 0.f, 0.f); }
    } else {
      const float* hr = hrow_ptr(p, row);
#pragma unroll
      for (int q = 0; q < 4; ++q) {
        if (row < RREAL) {
          {
            const float* tp_ = tmp + (size_t)row * D + q * 256 + lane * 4;
            t[q] = make_float4(__builtin_nontemporal_load(tp_), __builtin_nontemporal_load(tp_ + 1), __builtin_nontemporal_load(tp_ + 2), __builtin_nontemporal_load(tp_ + 3));
          }
        } else {
          const float* pp = (const float*)(p.ws + WS_PART) + (size_t)(row - RREAL) * D + q * 256 + lane * 4;
          float4 a = *reinterpret_cast<const float4*>(pp);
          for (int kc = 1; kc < nparts; ++kc) {
            const float4 c = *reinterpret_cast<const float4*>(pp + (size_t)kc * 128 * 1024);
            a.x += c.x; a.y += c.y; a.z += c.z; a.w += c.w;
          }
          t[q] = a;
        }
        h[q] = *reinterpret_cast<const float4*>(hr + q * 256 + lane * 4);
      }
    }
  };
  if (gw < R) loadrow(gw, tv, hv);
  if (gw + nw < R) loadrow(gw + nw, tvn, hvn);
  for (int row = gw; row < R; row += nw) {
    if (row + 2 * nw < R) loadrow(row + 2 * nw, tvm, hvm);
    float* hr = hrow_ptr(p, row);
    if (mode != 0) {
      float ss = 0.f;
#pragma unroll
      for (int q = 0; q < 4; ++q) ss += tv[q].x * tv[q].x + tv[q].y * tv[q].y + tv[q].z * tv[q].z + tv[q].w * tv[q].w;
      ss = wave_sum(ss);
      const float rs = rsqrtf(ss * (1.f / D) + EPS);
#pragma unroll
      for (int q = 0; q < 4; ++q) {
        hv[q].x += tv[q].x * rs * wpo[q].x;
        hv[q].y += tv[q].y * rs * wpo[q].y;
        hv[q].z += tv[q].z * rs * wpo[q].z;
        hv[q].w += tv[q].w * rs * wpo[q].w;
      }
    }
#pragma unroll
    for (int q = 0; q < 4; ++q) *reinterpret_cast<float4*>(hr + q * 256 + lane * 4) = hv[q];
    if (write_hn) {
      float ss = 0.f;
#pragma unroll
      for (int q = 0; q < 4; ++q) ss += hv[q].x * hv[q].x + hv[q].y * hv[q].y + hv[q].z * hv[q].z + hv[q].w * hv[q].w;
      ss = wave_sum(ss);
      const float rs = rsqrtf(ss * (1.f / D) + EPS);
#pragma unroll
      for (int q = 0; q < 4; ++q) {
        uint2 o;
        o.x = pack2(hv[q].x * rs * wpr[q].x, hv[q].y * rs * wpr[q].y);
        o.y = pack2(hv[q].z * rs * wpr[q].z, hv[q].w * rs * wpr[q].w);
        *reinterpret_cast<uint2*>(hn + (size_t)row * D + q * 256 + lane * 4) = o;
      }
    }
#pragma unroll
    for (int q = 0; q < 4; ++q) { tv[q] = tvn[q]; hv[q] = hvn[q]; tvn[q] = tvm[q]; hvn[q] = hvm[q]; }
  }
}

constexpr size_t WS_W2T = WS_WA - 196608;
constexpr size_t WS_A2T = WS_W2T + 32768;
constexpr size_t WS_G2T = WS_A2T + 32768;
constexpr size_t WS_WAT = WS_G2T + 65536;
constexpr size_t WS_WXT = WS_WAT + 32768;
static_assert(WS_W2T >= WS_ROPE + (size_t)T * 16 * 8, "small weights overlap rope");
constexpr int LSTR = 264;

constexpr int PMS = 516;
__device__ __forceinline__ float tanh_fast(float x) { return 1.f - 2.f * __builtin_amdgcn_rcpf(1.f + __expf(2.f * x)); }
__device__ __forceinline__ float softplus_fast(float x) { return fmaxf(x, 0.f) + __logf(1.f + __expf(-fabsf(x))); }
__device__ __forceinline__ uint2 ld_u2(const bf16_t* q) { return *reinterpret_cast<const uint2*>(q); }

__device__ __forceinline__ void prep_unit(CP p, int l, int u, char* smem) {
  float* pm = (float*)smem;
  bf16_t* latA = (bf16_t*)(smem + 16 * PMS * 4);
  bf16_t* xcA = latA + 16 * LSTR;
  const int tid = tidx(), lane = tid & 63, wid = tid >> 6, fr = lane & 15, fq = lane >> 4;
  const int b = u / 129, t0 = (u % 129) * 16;
  const int r0 = rowof(b, t0);
  const bf16_t* proj = (const bf16_t*)(p.ws + WS_PROJ);
  bf16_t* RW = (bf16_t*)(p.ws + WS_RW);
  bf16_t* SS = (bf16_t*)(p.ws + WS_SS);
  bf16_t* LR = (bf16_t*)(p.ws + WS_LR);
  bf16_t* RG = (bf16_t*)(p.ws + WS_RG);
  float* RC = (float*)(p.ws + WS_RC);
  float* SD = (float*)(p.ws + WS_SD);
  const int rm1 = (t0 > 0) ? rowof(b, t0 - 1) : 0, rm2 = (t0 > 0) ? rowof(b, t0 - 2) : 0, rm3 = (t0 > 0) ? rowof(b, t0 - 3) : 0;
  const float pz = (t0 > 0) ? 1.f : 0.f;
  half_barrier(smem);
  unsigned ra[2][17];
  unsigned rc[3][19];
  int coff[3];
#pragma unroll
  for (int q = 0; q < 2; ++q) {
    const int col = 2 * tid + q * 512;
    ra[q][0] = *reinterpret_cast<const unsigned*>(proj + (size_t)rm1 * PJ + OFF_RW + col);
#pragma unroll
    for (int tt = 0; tt < 16; ++tt) ra[q][1 + tt] = *reinterpret_cast<const unsigned*>(proj + (size_t)(r0 + tt) * PJ + OFF_RW + col);
  }
#pragma unroll
  for (int q = 0; q < 3; ++q) {
    const bool is_lru = (q == 2);
    const int pr = is_lru ? (tid & 127) : ((tid + q * 256) % 384);
    coff[q] = (is_lru ? OFF_LRU : OFF_XBC) + 2 * pr;
    rc[q][0] = *reinterpret_cast<const unsigned*>(proj + (size_t)rm3 * PJ + coff[q]);
    rc[q][1] = *reinterpret_cast<const unsigned*>(proj + (size_t)rm2 * PJ + coff[q]);
    rc[q][2] = *reinterpret_cast<const unsigned*>(proj + (size_t)rm1 * PJ + coff[q]);
#pragma unroll
    for (int tt = 0; tt < 16; ++tt) rc[q][3 + tt] = *reinterpret_cast<const unsigned*>(proj + (size_t)(r0 + tt) * PJ + coff[q]);
  }
  const bf16_t dtraw = proj[(size_t)(r0 + ((tid >> 2) & 15)) * PJ + OFF_DT + (tid & 3)];
  {
    const float* mu = p.in[14] + l * 1024;
#pragma unroll
    for (int q = 0; q < 2; ++q) {
      const int col = 2 * tid + q * 512;
      const float2 m = *reinterpret_cast<const float2*>(mu + col);
      const unsigned pw = ra[q][0];
      float p0 = pz * lo2f(pw), p1 = pz * hi2f(pw);
#pragma unroll
      for (int tt = 0; tt < 16; ++tt) {
        const unsigned cw_ = ra[q][1 + tt];
        const float c0 = lo2f(cw_), c1 = hi2f(cw_);
        const float v0 = c0 + (p0 - c0) * m.x, v1 = c1 + (p1 - c1) * m.y;
        p0 = c0; p1 = c1;
        if (q == 0) {
          *reinterpret_cast<float2*>(pm + tt * PMS + col) = make_float2(v0, v1);
        } else if (tid < 128) {
          *reinterpret_cast<unsigned*>(RW + (size_t)(r0 + tt) * 1536 + 1280 + 2 * tid) = pack2(v0, v1);
        } else {
          const int i = 2 * (tid - 128);
          float a0, a1;
          if (i < 64) { a0 = tanh_fast(v0); a1 = tanh_fast(v1); }
          else if (i < 128) { a0 = v0; a1 = v1; }
          else { a0 = sigmoidf_(v0); a1 = sigmoidf_(v1); }
          *reinterpret_cast<unsigned*>(latA + tt * LSTR + i) = pack2(a0, a1);
        }
      }
    }
  }
  {
#pragma unroll
    for (int q = 0; q < 3; ++q) {
      const bool is_lru = (q == 2);
      const int pr = is_lru ? tid : tid + q * 256;
      const bool act = is_lru ? (tid < 128) : (pr < 384);
      if (act) {
        const int ch = 2 * pr;
        const int C = is_lru ? 256 : 768;
        const float* cw = is_lru ? (p.in[25] + l * 4 * 256) : (p.in[8] + l * 4 * 768);
        const float2 cb = *reinterpret_cast<const float2*>((is_lru ? p.in[26] + l * 256 : p.in[9] + l * 768) + ch);
        const float2 w0 = *reinterpret_cast<const float2*>(cw + ch), w1 = *reinterpret_cast<const float2*>(cw + C + ch);
        const float2 w2 = *reinterpret_cast<const float2*>(cw + 2 * C + ch), w3 = *reinterpret_cast<const float2*>(cw + 3 * C + ch);
        const unsigned u0 = rc[q][0], u1 = rc[q][1], u2 = rc[q][2];
        float x0a = pz * lo2f(u0), x0b = pz * hi2f(u0), x1a = pz * lo2f(u1), x1b = pz * hi2f(u1), x2a = pz * lo2f(u2), x2b = pz * hi2f(u2);
#pragma unroll
        for (int tt = 0; tt < 16; ++tt) {
          const unsigned u3 = rc[q][3 + tt];
          const float x3a = lo2f(u3), x3b = hi2f(u3);
          const float ya = cb.x + w0.x * x0a + w1.x * x1a + w2.x * x2a + w3.x * x3a;
          const float yb = cb.y + w0.y * x0b + w1.y * x1b + w2.y * x2b + w3.y * x3b;
          if (is_lru) *reinterpret_cast<unsigned*>(xcA + tt * LSTR + ch) = pack2(ya, yb);
          else *reinterpret_cast<unsigned*>(SS + (size_t)(r0 + tt) * 768 + ch) = pack2(siluf_(ya), siluf_(yb));
          x0a = x1a; x0b = x1b; x1a = x2a; x1b = x2b; x2a = x3a; x2b = x3b;
        }
      }
    }
    if (tid < 64) {
      const int tt = tid >> 2, hh = tid & 3;
      const float v = bf2f(dtraw) + p.in[10][l * 4 + hh];
      SD[(size_t)(r0 + tt) * 4 + hh] = softplus_fast(v);
    }
  }
  half_barrier(smem);
  f32x4 accw[4], acca[4], accg[4], accr[4], acci[4];
#pragma unroll
  for (int mf = 0; mf < 4; ++mf) {
    accw[mf] = f32x4{0.f, 0.f, 0.f, 0.f}; acca[mf] = accw[mf]; accg[mf] = accw[mf]; accr[mf] = accw[mf]; acci[mf] = accw[mf];
  }
  {
    const bf16_t* W2T = (const bf16_t*)(p.ws + WS_W2T);
    const bf16_t* A2T = (const bf16_t*)(p.ws + WS_A2T);
    const bf16_t* G2T = (const bf16_t*)(p.ws + WS_G2T);
    const bf16_t* WAT = (const bf16_t*)(p.ws + WS_WAT);
    const bf16_t* WXT = (const bf16_t*)(p.ws + WS_WXT);
    bf16x8 al[8], ax[2];
#pragma unroll
    for (int ks = 0; ks < 8; ++ks) al[ks] = *reinterpret_cast<const bf16x8*>(latA + fr * LSTR + ks * 32 + fq * 8);
#pragma unroll
    for (int ks = 0; ks < 2; ++ks) ax[ks] = *reinterpret_cast<const bf16x8*>(xcA + fr * LSTR + wid * 64 + ks * 32 + fq * 8);
#pragma unroll
    for (int mf = 0; mf < 4; ++mf) {
      const int n = wid * 64 + mf * 16 + fr;
#pragma unroll
      for (int ks = 0; ks < 2; ++ks) {
        const bf16x8 bw = *reinterpret_cast<const bf16x8*>(W2T + n * 64 + ks * 32 + fq * 8);
        const bf16x8 ba = *reinterpret_cast<const bf16x8*>(A2T + n * 64 + ks * 32 + fq * 8);
        const bf16x8 br = *reinterpret_cast<const bf16x8*>(WAT + n * 64 + ks * 32 + fq * 8);
        const bf16x8 bi = *reinterpret_cast<const bf16x8*>(WXT + n * 64 + ks * 32 + fq * 8);
        accw[mf] = __builtin_amdgcn_mfma_f32_16x16x32_bf16(bw, al[ks], accw[mf], 0, 0, 0);
        acca[mf] = __builtin_amdgcn_mfma_f32_16x16x32_bf16(ba, al[2 + ks], acca[mf], 0, 0, 0);
        accr[mf] = __builtin_amdgcn_mfma_f32_16x16x32_bf16(br, ax[ks], accr[mf], 0, 0, 0);
        acci[mf] = __builtin_amdgcn_mfma_f32_16x16x32_bf16(bi, ax[ks], acci[mf], 0, 0, 0);
      }
#pragma unroll
      for (int ks = 0; ks < 4; ++ks) {
        const bf16x8 bg = *reinterpret_cast<const bf16x8*>(G2T + n * 128 + ks * 32 + fq * 8);
        accg[mf] = __builtin_amdgcn_mfma_f32_16x16x32_bf16(bg, al[4 + ks], accg[mf], 0, 0, 0);
      }
    }
  }
  {
    const int tt = fr;
    const size_t row = (size_t)(r0 + tt);
    float kkv[16], kpv[16], avv[16], rv[16];
    float ss = 0.f, cf = 0.f;
#pragma unroll
    for (int mf = 0; mf < 4; ++mf) {
      const int c = wid * 64 + mf * 16 + fq * 4;
      const float4 r4 = *reinterpret_cast<const float4*>(pm + tt * PMS + c);
      const float4 k4 = *reinterpret_cast<const float4*>(pm + tt * PMS + 256 + c);
      const float4 a0 = *reinterpret_cast<const float4*>(p.in[17] + l * 256 + c);
      const float4 kkc = *reinterpret_cast<const float4*>(p.in[20] + l * 256 + c);
      const float4 kac = *reinterpret_cast<const float4*>(p.in[21] + l * 256 + c);
      const float4 rkc = *reinterpret_cast<const float4*>(p.in[22] + l * 256 + c);
      const float rr_[4] = {r4.x, r4.y, r4.z, r4.w}, kk_[4] = {k4.x, k4.y, k4.z, k4.w};
      const float a0_[4] = {a0.x, a0.y, a0.z, a0.w}, kkc_[4] = {kkc.x, kkc.y, kkc.z, kkc.w};
      const float kac_[4] = {kac.x, kac.y, kac.z, kac.w}, rkc_[4] = {rkc.x, rkc.y, rkc.z, rkc.w};
#pragma unroll
      for (int j = 0; j < 4; ++j) {
        const int x = mf * 4 + j;
        rv[x] = rr_[j];
        avv[x] = sigmoidf_(a0_[j] + acca[mf][j]);
        kkv[x] = kk_[j] * kkc_[j];
        ss += kkv[x] * kkv[x];
        kpv[x] = kk_[j] * (1.f + (avv[x] - 1.f) * kac_[j]);
        cf += rv[x] * kpv[x] * rkc_[j];
      }
    }
    ss += __shfl_xor(ss, 16, 64); ss += __shfl_xor(ss, 32, 64);
    cf += __shfl_xor(cf, 16, 64); cf += __shfl_xor(cf, 32, 64);
    const float inv = 1.f / fmaxf(sqrtf(ss), 1e-12f);
    float4 w0a[4], baa[4], bxa[4], lama[4];
#pragma unroll
    for (int mf = 0; mf < 4; ++mf) {
      const int c = wid * 64 + mf * 16 + fq * 4;
      w0a[mf] = *reinterpret_cast<const float4*>(p.in[15] + l * 256 + c);
      baa[mf] = *reinterpret_cast<const float4*>(p.in[28] + l * 256 + c);
      bxa[mf] = *reinterpret_cast<const float4*>(p.in[30] + l * 256 + c);
      lama[mf] = *reinterpret_cast<const float4*>(p.in[31] + l * 256 + c);
    }
    if (fq == 0) RC[row * 4 + wid] = cf;
#pragma unroll
    for (int mf = 0; mf < 4; ++mf) {
      const int c = wid * 64 + mf * 16 + fq * 4;
      const float4 w0 = w0a[mf], ba = baa[mf], bx = bxa[mf], lam = lama[mf];
      const float w0_[4] = {w0.x, w0.y, w0.z, w0.w}, ba_[4] = {ba.x, ba.y, ba.z, ba.w};
      const float bx_[4] = {bx.x, bx.y, bx.z, bx.w}, lam_[4] = {lam.x, lam.y, lam.z, lam.w};
      const uint2 xcr = *reinterpret_cast<const uint2*>(xcA + tt * LSTR + c);
      const float xc_[4] = {lo2f(xcr.x), hi2f(xcr.x), lo2f(xcr.y), hi2f(xcr.y)};
      float omw[4], kn[4], bb[4], la[4], uu[4];
#pragma unroll
      for (int j = 0; j < 4; ++j) {
        const int x = mf * 4 + j;
        const float wv = w0_[j] + accw[mf][j];
        const float w = -softplus_fast(-wv) - 0.5f;
        omw[j] = 1.f - __expf(-__expf(w));
        kn[j] = kkv[x] * inv;
        bb[j] = kn[j] * avv[x];
        const float rr = sigmoidf_(accr[mf][j] + ba_[j]), ii = sigmoidf_(acci[mf][j] + bx_[j]);
        la[j] = -8.f * rr * softplus_fast(-lam_[j]);
        uu[j] = sqrtf(fmaxf(1.f - __expf(2.f * la[j]), 0.f)) * (ii * xc_[j]);
      }
      bf16_t* o = RW + row * 1536 + c;
      *reinterpret_cast<uint2*>(o) = make_uint2(pack2(omw[0], omw[1]), pack2(omw[2], omw[3]));
      *reinterpret_cast<uint2*>(o + 256) = make_uint2(pack2(kn[0], kn[1]), pack2(kn[2], kn[3]));
      *reinterpret_cast<uint2*>(o + 512) = make_uint2(pack2(bb[0], bb[1]), pack2(bb[2], bb[3]));
      *reinterpret_cast<uint2*>(o + 768) = make_uint2(pack2(kpv[mf * 4], kpv[mf * 4 + 1]), pack2(kpv[mf * 4 + 2], kpv[mf * 4 + 3]));
      *reinterpret_cast<uint2*>(o + 1024) = make_uint2(pack2(rv[mf * 4], rv[mf * 4 + 1]), pack2(rv[mf * 4 + 2], rv[mf * 4 + 3]));
      *reinterpret_cast<uint2*>(RG + row * 256 + c) = make_uint2(pack2(accg[mf][0], accg[mf][1]), pack2(accg[mf][2], accg[mf][3]));
      *reinterpret_cast<uint2*>(LR + row * 512 + c) = make_uint2(pack2(la[0], la[1]), pack2(la[2], la[3]));
      *reinterpret_cast<uint2*>(LR + row * 512 + 256 + c) = make_uint2(pack2(uu[0], uu[1]), pack2(uu[2], uu[3]));
    }
  }
}

__device__ __forceinline__ void rwkv_scan_unit(CP p, int u, char* smem) {
  float* buf = (float*)smem;
  const int tid = tidx(), wid = tid >> 6, lane = tid & 63, i = lane >> 4, j = lane & 15;
  const int b = u >> 4, h = (u >> 2) & 3, q = u & 3;
  const int rowv = q * 16 + wid * 4 + i;
  const bf16_t* RW = (const bf16_t*)(p.ws + WS_RW);
  bf16_t* Y = (bf16_t*)(p.ws + WS_Y);
  float s0 = 0.f, s1 = 0.f, s2 = 0.f, s3 = 0.f;
  uint4 st[3];
  auto gload = [&](int c) {
    const int rb = rowof(b, c * 16);
#pragma unroll
    for (int x = 0; x < 3; ++x) {
      const int e = tid + x * 256, tok = e / 48, rem = e % 48, vec = rem >> 3, part = rem & 7;
      st[x] = *reinterpret_cast<const uint4*>(RW + (size_t)(rb + tok) * 1536 + vec * 256 + h * 64 + part * 8);
    }
  };
  auto lwrite = [&](int bi) {
#pragma unroll
    for (int x = 0; x < 3; ++x) {
      const int e = tid + x * 256, tok = e / 48, rem = e % 48, vec = rem >> 3, part = rem & 7;
      float* d = buf + bi * 6144 + tok * 384 + vec * 64 + part * 8;
      *reinterpret_cast<float4*>(d) = make_float4(lo2f(st[x].x), hi2f(st[x].x), lo2f(st[x].y), hi2f(st[x].y));
      *reinterpret_cast<float4*>(d + 4) = make_float4(lo2f(st[x].z), hi2f(st[x].z), lo2f(st[x].w), hi2f(st[x].w));
    }
  };
  half_barrier(smem);
  gload(0);
  lwrite(0);
  half_barrier(smem);
  constexpr int NCH = T / 16;
  for (int c = 0; c < NCH; ++c) {
    if (c + 1 < NCH) gload(c + 1);
    const float* cb = buf + (c & 1) * 6144;
    float ykeep = 0.f;
    float4 om = *reinterpret_cast<const float4*>(cb + j * 4);
    float4 kk = *reinterpret_cast<const float4*>(cb + 64 + j * 4);
    float4 bb = *reinterpret_cast<const float4*>(cb + 128 + j * 4);
    float4 kp = *reinterpret_cast<const float4*>(cb + 192 + j * 4);
    float4 rr = *reinterpret_cast<const float4*>(cb + 256 + j * 4);
    float vv = cb[320 + rowv];
#pragma unroll 2
    for (int s = 0; s < 16; ++s) {
      const float* sb = cb + (s + 1) * 384;
      const float4 om_n = *reinterpret_cast<const float4*>(sb + j * 4);
      const float4 kk_n = *reinterpret_cast<const float4*>(sb + 64 + j * 4);
      const float4 bb_n = *reinterpret_cast<const float4*>(sb + 128 + j * 4);
      const float4 kp_n = *reinterpret_cast<const float4*>(sb + 192 + j * 4);
      const float4 rr_n = *reinterpret_cast<const float4*>(sb + 256 + j * 4);
      const float vv_n = sb[320 + rowv];
      __builtin_amdgcn_sched_barrier(0);
      float d = s0 * kk.x + s1 * kk.y + s2 * kk.z + s3 * kk.w;
      d = allreduce16(d);
      const float sa = -d;
      s0 = fmaf(-s0, om.x, s0); s1 = fmaf(-s1, om.y, s1); s2 = fmaf(-s2, om.z, s2); s3 = fmaf(-s3, om.w, s3);
      s0 = fmaf(sa, bb.x, s0); s1 = fmaf(sa, bb.y, s1); s2 = fmaf(sa, bb.z, s2); s3 = fmaf(sa, bb.w, s3);
      s0 = fmaf(vv, kp.x, s0); s1 = fmaf(vv, kp.y, s1); s2 = fmaf(vv, kp.z, s2); s3 = fmaf(vv, kp.w, s3);
      float y = s0 * rr.x + s1 * rr.y + s2 * rr.z + s3 * rr.w;
      y = allreduce16(y);
      if (j == s) ykeep = y;
      om = om_n; kk = kk_n; bb = bb_n; kp = kp_n; rr = rr_n; vv = vv_n;
    }
    Y[(size_t)(rowof(b, c * 16) + j) * 1024 + 256 + h * 64 + rowv] = f2bf(ykeep);
    if (c + 1 < NCH) lwrite((c + 1) & 1);
    half_barrier(smem);
  }
}

__device__ __forceinline__ void ssd_scan_unit(CP p, int l, int u, char* smem) {
  constexpr int SST = 296;
  float* buf = (float*)smem;
  const int tid = tidx(), wid = tid >> 6, lane = tid & 63, i = lane >> 4, j = lane & 15;
  const int b = u >> 4, h = (u >> 2) & 3, q = u & 3, g = h >> 1;
  const int prow = wid * 4 + i;
  const bf16_t* SS = (const bf16_t*)(p.ws + WS_SS);
  const float* SD = (const float*)(p.ws + WS_SD);
  bf16_t* Y = (bf16_t*)(p.ws + WS_Y);
  const float Ah = -__expf(p.in[11][l * 4 + h]);
  const float Dh = p.in[12][l * 4 + h];
  float hs[8];
#pragma unroll
  for (int n = 0; n < 8; ++n) hs[n] = 0.f;
  uint4 st[2];
  unsigned short stxr = 0;
  float stdt = 0.f;
  auto gload = [&](int c) {
    const int rb = rowof(b, c * 16);
#pragma unroll
    for (int x = 0; x < 2; ++x) {
      const int e = tid + x * 256, tok = e >> 5, rem = e & 31, which = rem >> 4, part = rem & 15;
      st[x] = *reinterpret_cast<const uint4*>(SS + (size_t)(rb + tok) * 768 + 256 + which * 256 + g * 128 + part * 8);
    }
    {
      const int tok = tid >> 4, pp = tid & 15;
      stxr = SS[(size_t)(rb + tok) * 768 + h * 64 + q * 16 + pp];
      stdt = SD[(size_t)(rb + tok) * 4 + h];
    }
  };
  auto lwrite = [&](int bi) {
#pragma unroll
    for (int x = 0; x < 2; ++x) {
      const int e = tid + x * 256, tok = e >> 5, rem = e & 31, which = rem >> 4, part = rem & 15;
      float* d = buf + bi * 16 * SST + tok * SST + which * 128 + part * 8;
      *reinterpret_cast<float4*>(d) = make_float4(lo2f(st[x].x), hi2f(st[x].x), lo2f(st[x].y), hi2f(st[x].y));
      *reinterpret_cast<float4*>(d + 4) = make_float4(lo2f(st[x].z), hi2f(st[x].z), lo2f(st[x].w), hi2f(st[x].w));
    }
    {
      const int tok = tid >> 4, pp = tid & 15;
      float* d = buf + bi * 16 * SST + tok * SST;
      const float stx = bf2f(stxr);
      d[256 + pp] = stx * stdt;
      d[272 + pp] = stx;
      if (pp == 0) d[288] = __expf(stdt * Ah);
    }
  };
  half_barrier(smem);
  gload(0);
  lwrite(0);
  half_barrier(smem);
  constexpr int NCH = T / 16;
  for (int c = 0; c < NCH; ++c) {
    if (c + 1 < NCH) gload(c + 1);
    const float* cb = buf + (c & 1) * 16 * SST;
    float ykeep = 0.f;
    float4 B0 = *reinterpret_cast<const float4*>(cb + j * 4), B1 = *reinterpret_cast<const float4*>(cb + 64 + j * 4);
    float4 C0 = *reinterpret_cast<const float4*>(cb + 128 + j * 4), C1 = *reinterpret_cast<const float4*>(cb + 192 + j * 4);
    float xdt = cb[256 + prow], xr = cb[272 + prow], a = cb[288];
#pragma unroll 2
    for (int s = 0; s < 16; ++s) {
      const float* sb = cb + (s + 1) * SST;
      const float4 B0n = *reinterpret_cast<const float4*>(sb + j * 4), B1n = *reinterpret_cast<const float4*>(sb + 64 + j * 4);
      const float4 C0n = *reinterpret_cast<const float4*>(sb + 128 + j * 4), C1n = *reinterpret_cast<const float4*>(sb + 192 + j * 4);
      const float xdtn = sb[256 + prow], xrn = sb[272 + prow], an = sb[288];
      __builtin_amdgcn_sched_barrier(0);
      hs[0] = fmaf(a, hs[0], xdt * B0.x); hs[1] = fmaf(a, hs[1], xdt * B0.y); hs[2] = fmaf(a, hs[2], xdt * B0.z); hs[3] = fmaf(a, hs[3], xdt * B0.w);
      hs[4] = fmaf(a, hs[4], xdt * B1.x); hs[5] = fmaf(a, hs[5], xdt * B1.y); hs[6] = fmaf(a, hs[6], xdt * B1.z); hs[7] = fmaf(a, hs[7], xdt * B1.w);
      float y = hs[0] * C0.x + hs[1] * C0.y + hs[2] * C0.z + hs[3] * C0.w + hs[4] * C1.x + hs[5] * C1.y + hs[6] * C1.z + hs[7] * C1.w;
      y = allreduce16(y);
      y = fmaf(Dh, xr, y);
      if (j == s) ykeep = y;
      B0 = B0n; B1 = B1n; C0 = C0n; C1 = C1n; xdt = xdtn; xr = xrn; a = an;
    }
    Y[(size_t)(rowof(b, c * 16) + j) * 1024 + h * 64 + q * 16 + prow] = f2bf(ykeep);
    if (c + 1 < NCH) lwrite((c + 1) & 1);
    half_barrier(smem);
  }
}

__device__ __forceinline__ void ret_scan_unit(CP p, int l, int u, char* smem) {
  float* buf = (float*)smem;
  float* ybuf0 = buf + 2 * 16 * 128;
  const int tid = tidx(), e = tid >> 2, dsl = tid & 3;
  const int b = u >> 2, h = u & 3;
  const bf16_t* proj = (const bf16_t*)(p.ws + WS_PROJ);
  const float* rope = (const float*)(p.ws + WS_ROPE);
  bf16_t* Y = (bf16_t*)(p.ws + WS_Y);
  const float gdec = 1.f - exp2f(-5.f - (float)h);
  float S[8];
#pragma unroll
  for (int n = 0; n < 8; ++n) S[n] = 0.f;
  const int stok = tid >> 4, spart = tid & 15;
  uint4 sa_, sb_;
  float4 rp0, rp1, rp2, rp3;
  uint2 gg_n, gg_c;
  const int s_qk = (spart >> 2) & 1, s_pp = spart & 3;
  const int offa = (spart < 8) ? (OFF_RET + s_qk * 128 + h * 32 + s_pp * 8) : (OFF_RET + 256 + h * 64 + (spart - 8) * 8);
  const int offb = (spart < 8) ? (OFF_RET + s_qk * 128 + h * 32 + (s_pp ^ 2) * 8) : offa;
  const int ech = h * 64 + spart * 4;
  const float4 gw = *reinterpret_cast<const float4*>(p.in[32] + l * 256 + ech);
  auto gload = [&](int c) {
    const size_t row = (size_t)(rowof(b, c * 16) + stok);
    sa_ = *reinterpret_cast<const uint4*>(proj + row * PJ + offa);
    sb_ = *reinterpret_cast<const uint4*>(proj + row * PJ + offb);
    const float* rpp = rope + ((size_t)(c * 16 + stok) * 16 + (s_pp & 1) * 8) * 2;
    rp0 = *reinterpret_cast<const float4*>(rpp);
    rp1 = *reinterpret_cast<const float4*>(rpp + 4);
    rp2 = *reinterpret_cast<const float4*>(rpp + 8);
    rp3 = *reinterpret_cast<const float4*>(rpp + 12);
    gg_n = *reinterpret_cast<const uint2*>(proj + row * PJ + OFF_RET + 512 + ech);
  };
  auto lwrite = [&](int bi) {
    float* d = buf + bi * 2048 + stok * 128;
    float a[8];
    a[0] = lo2f(sa_.x); a[1] = hi2f(sa_.x); a[2] = lo2f(sa_.y); a[3] = hi2f(sa_.y);
    a[4] = lo2f(sa_.z); a[5] = hi2f(sa_.z); a[6] = lo2f(sa_.w); a[7] = hi2f(sa_.w);
    if (spart < 8) {
      float o[8];
      o[0] = lo2f(sb_.x); o[1] = hi2f(sb_.x); o[2] = lo2f(sb_.y); o[3] = hi2f(sb_.y);
      o[4] = lo2f(sb_.z); o[5] = hi2f(sb_.z); o[6] = lo2f(sb_.w); o[7] = hi2f(sb_.w);
      const float cs[16] = {rp0.x, rp0.y, rp0.z, rp0.w, rp1.x, rp1.y, rp1.z, rp1.w, rp2.x, rp2.y, rp2.z, rp2.w, rp3.x, rp3.y, rp3.z, rp3.w};
      const float sc = s_qk ? 0.17677669529663687f : 1.f;
      float r[8];
#pragma unroll
      for (int n = 0; n < 8; ++n) {
        r[n] = (s_pp < 2) ? (a[n] * cs[2 * n] - o[n] * cs[2 * n + 1]) : (o[n] * cs[2 * n + 1] + a[n] * cs[2 * n]);
        r[n] *= sc;
      }
      float* dd = d + s_qk * 32 + s_pp * 8;
      *reinterpret_cast<float4*>(dd) = make_float4(r[0], r[1], r[2], r[3]);
      *reinterpret_cast<float4*>(dd + 4) = make_float4(r[4], r[5], r[6], r[7]);
    } else {
      float* dd = d + 64 + (spart - 8) * 8;
      *reinterpret_cast<float4*>(dd) = make_float4(a[0], a[1], a[2], a[3]);
      *reinterpret_cast<float4*>(dd + 4) = make_float4(a[4], a[5], a[6], a[7]);
    }
  };
  half_barrier(smem);
  gload(0);
  lwrite(0);
  gg_c = gg_n;
  half_barrier(smem);
  constexpr int NCH = T / 16;
  for (int c = 0; c < NCH; ++c) {
    if (c + 1 < NCH) gload(c + 1);
    const float* cb = buf + (c & 1) * 2048;
    float* ybuf = ybuf0 + (c & 1) * 1024;
    float4 q0 = *reinterpret_cast<const float4*>(cb + dsl * 8), q1 = *reinterpret_cast<const float4*>(cb + dsl * 8 + 4);
    float4 k0 = *reinterpret_cast<const float4*>(cb + 32 + dsl * 8), k1 = *reinterpret_cast<const float4*>(cb + 32 + dsl * 8 + 4);
    float v = cb[64 + e];
#pragma unroll 2
    for (int s = 0; s < 16; ++s) {
      const float* sb = cb + (s + 1) * 128;
      const float4 q0n = *reinterpret_cast<const float4*>(sb + dsl * 8), q1n = *reinterpret_cast<const float4*>(sb + dsl * 8 + 4);
      const float4 k0n = *reinterpret_cast<const float4*>(sb + 32 + dsl * 8), k1n = *reinterpret_cast<const float4*>(sb + 32 + dsl * 8 + 4);
      const float vn = sb[64 + e];
      __builtin_amdgcn_sched_barrier(0);
      S[0] = fmaf(gdec, S[0], k0.x * v); S[1] = fmaf(gdec, S[1], k0.y * v); S[2] = fmaf(gdec, S[2], k0.z * v); S[3] = fmaf(gdec, S[3], k0.w * v);
      S[4] = fmaf(gdec, S[4], k1.x * v); S[5] = fmaf(gdec, S[5], k1.y * v); S[6] = fmaf(gdec, S[6], k1.z * v); S[7] = fmaf(gdec, S[7], k1.w * v);
      float y = S[0] * q0.x + S[1] * q0.y + S[2] * q0.z + S[3] * q0.w + S[4] * q1.x + S[5] * q1.y + S[6] * q1.z + S[7] * q1.w;
      y = allreduce4(y);
      ybuf[s * 64 + e] = y;
      q0 = q0n; q1 = q1n; k0 = k0n; k1 = k1n; v = vn;
    }
    if (c + 1 < NCH) lwrite((c + 1) & 1);
    half_barrier(smem);
    {
      const float4 yv = *reinterpret_cast<const float4*>(ybuf + stok * 64 + spart * 4);
      const float mu = allreduce16(yv.x + yv.y + yv.z + yv.w) * (1.f / 64.f);
      const float d0 = yv.x - mu, d1 = yv.y - mu, d2 = yv.z - mu, d3 = yv.w - mu;
      const float var = allreduce16(d0 * d0 + d1 * d1 + d2 * d2 + d3 * d3) * (1.f / 64.f);
      const float rs = rsqrtf(var + 1e-5f);
      const size_t row = (size_t)(rowof(b, c * 16) + stok);
      uint2 o;
      o.x = pack2(d0 * rs * gw.x * siluf_(lo2f(gg_c.x)), d1 * rs * gw.y * siluf_(hi2f(gg_c.x)));
      o.y = pack2(d2 * rs * gw.z * siluf_(lo2f(gg_c.y)), d3 * rs * gw.w * siluf_(hi2f(gg_c.y)));
      *reinterpret_cast<uint2*>(Y + row * 1024 + 768 + ech) = o;
    }
    gg_c = gg_n;
  }
}


__device__ __forceinline__ void ret_mfma_unit(CP p, int l, int u, char* smem) {
  const int tid = tidx(), wv = tid >> 6, lane = tid & 63, r = lane & 15, fq = lane >> 4;
  const int bh = u * 2 + (wv >> 1), b = bh >> 2, h = bh & 3, eh = wv & 1;
  char* wl = smem + wv * 8192;
  bf16_t* KT = (bf16_t*)wl;
  bf16_t* VT = (bf16_t*)(wl + 1024);
  bf16_t* PT = (bf16_t*)(wl + 3072);
  bf16_t* ST = (bf16_t*)(wl + 4096);
  const bf16_t* proj = (const bf16_t*)(p.ws + WS_PROJ);
  const float* rope = (const float*)(p.ws + WS_ROPE);
  bf16_t* Y = (bf16_t*)(p.ws + WS_Y);
  half_barrier(smem);
  for (int i = lane; i < 512; i += 64) reinterpret_cast<unsigned*>(ST)[i] = 0u;
  const float lg = log2f(1.f - exp2f(-5.f - (float)h));
  const float dk = exp2f(lg * (float)(15 - r)), dq = exp2f(lg * (float)(r + 1)), d16 = exp2f(lg * 16.f);
  float pw[4];
#pragma unroll
  for (int jj = 0; jj < 4; ++jj) { const int t = fq * 4 + jj; pw[jj] = (r <= t) ? exp2f(lg * (float)(t - r)) : 0.f; }
  f32x4 Sacc[2][2];
#pragma unroll
  for (int mf = 0; mf < 2; ++mf)
#pragma unroll
    for (int nf = 0; nf < 2; ++nf) Sacc[mf][nf] = f32x4{0.f, 0.f, 0.f, 0.f};
  const bf16x8 zero8 = {0, 0, 0, 0, 0, 0, 0, 0};
  const bool lowk = fq < 2;
  uint4 qa, qb, ka, kb, v0, nqa, nqb, nka, nkb, nv0, mqa, mqb, mka, mkb, mv0;
  float4 rp0, rp1, rp2, rp3, nrp0, nrp1, nrp2, nrp3;
  constexpr int NCH = T / 16;
#define RET_GLOAD(c, QA, QB, KA, KB, V0) do { \
    const bf16_t* pr_ = proj + (size_t)(rowof(b, (c) * 16) + r) * PJ + OFF_RET; \
    QA = *reinterpret_cast<const uint4*>(pr_ + h * 32 + fq * 8); \
    QB = *reinterpret_cast<const uint4*>(pr_ + h * 32 + (fq ^ 2) * 8); \
    KA = *reinterpret_cast<const uint4*>(pr_ + 128 + h * 32 + fq * 8); \
    KB = *reinterpret_cast<const uint4*>(pr_ + 128 + h * 32 + (fq ^ 2) * 8); \
    V0 = *reinterpret_cast<const uint4*>(pr_ + 256 + h * 64 + eh * 32 + fq * 8); \
  } while (0)
#define RET_ROPE(c, R0, R1, R2, R3) do { \
    const float* rq_ = rope + ((size_t)((c) * 16 + r) * 16 + (fq & 1) * 8) * 2; \
    R0 = *reinterpret_cast<const float4*>(rq_); R1 = *reinterpret_cast<const float4*>(rq_ + 4); \
    R2 = *reinterpret_cast<const float4*>(rq_ + 8); R3 = *reinterpret_cast<const float4*>(rq_ + 12); \
  } while (0)
  RET_GLOAD(0, qa, qb, ka, kb, v0);
  RET_ROPE(0, rp0, rp1, rp2, rp3);
  RET_GLOAD(1, nqa, nqb, nka, nkb, nv0);
  for (int c = 0; c < NCH; ++c) {
    RET_GLOAD((c + 2 < NCH) ? c + 2 : c, mqa, mqb, mka, mkb, mv0);
    RET_ROPE((c + 1 < NCH) ? c + 1 : c, nrp0, nrp1, nrp2, nrp3);
    const float cs[16] = {rp0.x, rp0.y, rp0.z, rp0.w, rp1.x, rp1.y, rp1.z, rp1.w, rp2.x, rp2.y, rp2.z, rp2.w, rp3.x, rp3.y, rp3.z, rp3.w};
    const unsigned qaw[4] = {qa.x, qa.y, qa.z, qa.w}, qbw[4] = {qb.x, qb.y, qb.z, qb.w};
    const unsigned kaw[4] = {ka.x, ka.y, ka.z, ka.w}, kbw[4] = {kb.x, kb.y, kb.z, kb.w};
    float qf[8], kf[8];
#pragma unroll
    for (int n = 0; n < 8; ++n) {
      const float qo = (n & 1) ? hi2f(qaw[n >> 1]) : lo2f(qaw[n >> 1]);
      const float qp = (n & 1) ? hi2f(qbw[n >> 1]) : lo2f(qbw[n >> 1]);
      const float ko = (n & 1) ? hi2f(kaw[n >> 1]) : lo2f(kaw[n >> 1]);
      const float kp = (n & 1) ? hi2f(kbw[n >> 1]) : lo2f(kbw[n >> 1]);
      const float cc = cs[2 * n], sn = cs[2 * n + 1];
      qf[n] = lowk ? (qo * cc - qp * sn) : (qp * sn + qo * cc);
      kf[n] = (lowk ? (ko * cc - kp * sn) : (kp * sn + ko * cc)) * 0.17677669529663687f;
    }
    bf16x8 Qf, Kf, Qs;
#pragma unroll
    for (int n = 0; n < 8; ++n) { Qf[n] = (short)f2bf(qf[n]); Kf[n] = (short)f2bf(kf[n]); Qs[n] = (short)f2bf(qf[n] * dq); }
    f32x4 P = __builtin_amdgcn_mfma_f32_16x16x32_bf16(Qf, Kf, f32x4{0.f, 0.f, 0.f, 0.f}, 0, 0, 0);
#pragma unroll
    for (int jj = 0; jj < 4; ++jj) PT[(fq * 4 + jj) * 16 + r] = f2bf(P[jj] * pw[jj]);
#pragma unroll
    for (int n = 0; n < 8; ++n) KT[(fq * 8 + n) * 16 + r] = f2bf(kf[n] * dk);
    {
      const unsigned vw[4] = {v0.x, v0.y, v0.z, v0.w};
#pragma unroll
      for (int i = 0; i < 8; ++i) VT[(fq * 8 + i) * 16 + r] = (bf16_t)((i & 1) ? (vw[i >> 1] >> 16) : (vw[i >> 1] & 0xffffu));
    }
    asm volatile("s_waitcnt lgkmcnt(0)" ::: "memory");
    bf16x8 Pf = *reinterpret_cast<const bf16x8*>(PT + r * 16 + (fq & 1) * 8);
    Pf = lowk ? Pf : zero8;
    bf16x8 VTf[2], STf[2], KTf[2];
#pragma unroll
    for (int nf = 0; nf < 2; ++nf) {
      VTf[nf] = *reinterpret_cast<const bf16x8*>(VT + (nf * 16 + r) * 16 + (fq & 1) * 8);
      VTf[nf] = lowk ? VTf[nf] : zero8;
      STf[nf] = *reinterpret_cast<const bf16x8*>(ST + (nf * 16 + r) * 32 + fq * 8);
    }
#pragma unroll
    for (int mf = 0; mf < 2; ++mf) {
      KTf[mf] = *reinterpret_cast<const bf16x8*>(KT + (mf * 16 + r) * 16 + (fq & 1) * 8);
      KTf[mf] = lowk ? KTf[mf] : zero8;
    }
    asm volatile("s_waitcnt lgkmcnt(0)" ::: "memory");
    f32x4 Yv[2];
#pragma unroll
    for (int nf = 0; nf < 2; ++nf) {
      Yv[nf] = __builtin_amdgcn_mfma_f32_16x16x32_bf16(Qs, STf[nf], f32x4{0.f, 0.f, 0.f, 0.f}, 0, 0, 0);
      Yv[nf] = __builtin_amdgcn_mfma_f32_16x16x32_bf16(Pf, VTf[nf], Yv[nf], 0, 0, 0);
    }
#pragma unroll
    for (int mf = 0; mf < 2; ++mf)
#pragma unroll
      for (int nf = 0; nf < 2; ++nf) {
        Sacc[mf][nf] = Sacc[mf][nf] * d16;
        Sacc[mf][nf] = __builtin_amdgcn_mfma_f32_16x16x32_bf16(KTf[mf], VTf[nf], Sacc[mf][nf], 0, 0, 0);
        *reinterpret_cast<uint2*>(ST + (nf * 16 + r) * 32 + mf * 16 + fq * 4) =
            make_uint2(pack2(Sacc[mf][nf][0], Sacc[mf][nf][1]), pack2(Sacc[mf][nf][2], Sacc[mf][nf][3]));
      }
    const int rb = rowof(b, c * 16);
#pragma unroll
    for (int jj = 0; jj < 4; ++jj)
#pragma unroll
      for (int nf = 0; nf < 2; ++nf)
        Y[(size_t)(rb + fq * 4 + jj) * 1024 + 768 + h * 64 + eh * 32 + nf * 16 + r] = f2bf(Yv[nf][jj]);
    asm volatile("s_waitcnt lgkmcnt(0)" ::: "memory");
    qa = nqa; qb = nqb; ka = nka; kb = nkb; v0 = nv0;
    nqa = mqa; nqb = mqb; nka = mka; nkb = mkb; nv0 = mv0;
    rp0 = nrp0; rp1 = nrp1; rp2 = nrp2; rp3 = nrp3;
  }
#undef RET_ROPE
#undef RET_GLOAD
}

__device__ __forceinline__ float gelu_tanh(float x) {
  const float u = 0.7978845608028654f * (x + 0.044715f * x * x * x);
  return 0.5f * x * (1.f + tanhf(u));
}
__device__ __forceinline__ void lru_scan_unit(CP p, int u, char* smem) {
  float* segS = (float*)smem;
  float* segH = segS + 256;
  const int tid = tidx(), seg = tid >> 6, lane = tid & 63;
  const int b = u >> 2, ch = (u & 3) * 64 + lane;
  const bf16_t* LR = (const bf16_t*)(p.ws + WS_LR);
  const bf16_t* proj = (const bf16_t*)(p.ws + WS_PROJ);
  bf16_t* Y = (bf16_t*)(p.ws + WS_Y);
  constexpr int SEGL = T / 4;
  const int tb = seg * SEGL;
  half_barrier(smem);
  constexpr int LB = 12, NBAT = SEGL / LB;
  float hl = 0.f, S = 0.f;
  {
    unsigned short la[LB], uu[LB], lan[LB], uun[LB];
#pragma unroll
    for (int x = 0; x < LB; ++x) {
      const size_t row = (size_t)rowof(b, tb + x);
      la[x] = LR[row * 512 + ch]; uu[x] = LR[row * 512 + 256 + ch];
    }
    for (int k = 0; k < NBAT; ++k) {
      const int tn = tb + (k + 1 < NBAT ? k + 1 : k) * LB;
#pragma unroll
      for (int x = 0; x < LB; ++x) {
        const size_t row = (size_t)rowof(b, tn + x);
        lan[x] = LR[row * 512 + ch]; uun[x] = LR[row * 512 + 256 + ch];
      }
#pragma unroll
      for (int x = 0; x < LB; ++x) {
        const float l_ = bf2f(la[x]);
        hl = fmaf(__expf(l_), hl, bf2f(uu[x]));
        S += l_;
      }
#pragma unroll
      for (int x = 0; x < LB; ++x) { la[x] = lan[x]; uu[x] = uun[x]; }
    }
  }
  segS[seg * 64 + lane] = S;
  segH[seg * 64 + lane] = hl;
  half_barrier(smem);
  float hh = 0.f;
  for (int q = 0; q < seg; ++q) hh = fmaf(__expf(segS[q * 64 + lane]), hh, segH[q * 64 + lane]);
  {
    unsigned short la[LB], uu[LB], gb[LB], lan[LB], uun[LB], gbn[LB];
#pragma unroll
    for (int x = 0; x < LB; ++x) {
      const size_t row = (size_t)rowof(b, tb + x);
      la[x] = LR[row * 512 + ch]; uu[x] = LR[row * 512 + 256 + ch]; gb[x] = proj[row * PJ + OFF_LRU + 256 + ch];
    }
    for (int k = 0; k < NBAT; ++k) {
      const int tn = tb + (k + 1 < NBAT ? k + 1 : k) * LB;
#pragma unroll
      for (int x = 0; x < LB; ++x) {
        const size_t row = (size_t)rowof(b, tn + x);
        lan[x] = LR[row * 512 + ch]; uun[x] = LR[row * 512 + 256 + ch]; gbn[x] = proj[row * PJ + OFF_LRU + 256 + ch];
      }
#pragma unroll
      for (int x = 0; x < LB; ++x) {
        hh = fmaf(__expf(bf2f(la[x])), hh, bf2f(uu[x]));
        Y[(size_t)rowof(b, tb + k * LB + x) * 1024 + 512 + ch] = f2bf(hh * gelu_tanh(bf2f(gb[x])));
      }
#pragma unroll
      for (int x = 0; x < LB; ++x) { la[x] = lan[x]; uu[x] = uun[x]; gb[x] = gbn[x]; }
    }
  }
}

__device__ __forceinline__ void epi_phase(CP p, int l) {
  const int tid_ = tidx(); const int lane = tid_ & 63, gw = bidx() * 4 + (tid_ >> 6), nw = nvb() * 4;
  const bf16_t* proj = (const bf16_t*)(p.ws + WS_PROJ);
  const bf16_t* RW = (const bf16_t*)(p.ws + WS_RW);
  const bf16_t* RG = (const bf16_t*)(p.ws + WS_RG);
  const float* RC = (const float*)(p.ws + WS_RC);
  bf16_t* Y = (bf16_t*)(p.ws + WS_Y);
  const int c = lane * 4;
  const float4 nw4 = *reinterpret_cast<const float4*>(p.in[13] + l * 256 + c);
  const float4 lw4 = *reinterpret_cast<const float4*>(p.in[23] + l * 256 + c);
  const float4 lb4 = *reinterpret_cast<const float4*>(p.in[24] + l * 256 + c);
  for (int row = gw; row < R; row += nw) {
    {
      const uint2 yr = *reinterpret_cast<const uint2*>(Y + (size_t)row * 1024 + c);
      const uint2 zr = *reinterpret_cast<const uint2*>(proj + (size_t)row * PJ + OFF_Z + c);
      const float y0 = lo2f(yr.x) * siluf_(lo2f(zr.x)), y1 = hi2f(yr.x) * siluf_(hi2f(zr.x));
      const float y2 = lo2f(yr.y) * siluf_(lo2f(zr.y)), y3 = hi2f(yr.y) * siluf_(hi2f(zr.y));
      float ss = y0 * y0 + y1 * y1 + y2 * y2 + y3 * y3;
#pragma unroll
      for (int o = 16; o >= 1; o >>= 1) ss += __shfl_xor(ss, o, 64);
      const float rs = rsqrtf(ss * (1.f / 128.f) + EPS);
      uint2 o;
      o.x = pack2(y0 * rs * nw4.x, y1 * rs * nw4.y);
      o.y = pack2(y2 * rs * nw4.z, y3 * rs * nw4.w);
      *reinterpret_cast<uint2*>(Y + (size_t)row * 1024 + c) = o;
    }
    {
      const uint2 yr = *reinterpret_cast<const uint2*>(Y + (size_t)row * 1024 + 768 + c);
      const uint2 gr = *reinterpret_cast<const uint2*>(proj + (size_t)row * PJ + OFF_RET + 512 + c);
      const float4 gw = *reinterpret_cast<const float4*>(p.in[32] + l * 256 + c);
      const float y0 = lo2f(yr.x), y1 = hi2f(yr.x), y2 = lo2f(yr.y), y3 = hi2f(yr.y);
      float sm = y0 + y1 + y2 + y3;
#pragma unroll
      for (int o = 8; o >= 1; o >>= 1) sm += __shfl_xor(sm, o, 64);
      const float mu = sm * (1.f / 64.f);
      const float d0 = y0 - mu, d1 = y1 - mu, d2 = y2 - mu, d3 = y3 - mu;
      float vs = d0 * d0 + d1 * d1 + d2 * d2 + d3 * d3;
#pragma unroll
      for (int o = 8; o >= 1; o >>= 1) vs += __shfl_xor(vs, o, 64);
      const float rs = rsqrtf(vs * (1.f / 64.f) + 1e-5f);
      uint2 o;
      o.x = pack2(d0 * rs * gw.x * siluf_(lo2f(gr.x)), d1 * rs * gw.y * siluf_(hi2f(gr.x)));
      o.y = pack2(d2 * rs * gw.z * siluf_(lo2f(gr.y)), d3 * rs * gw.w * siluf_(hi2f(gr.y)));
      *reinterpret_cast<uint2*>(Y + (size_t)row * 1024 + 768 + c) = o;
    }
    {
      const uint2 yr = *reinterpret_cast<const uint2*>(Y + (size_t)row * 1024 + 256 + c);
      const float y0 = lo2f(yr.x), y1 = hi2f(yr.x), y2 = lo2f(yr.y), y3 = hi2f(yr.y);
      float sm = y0 + y1 + y2 + y3;
#pragma unroll
      for (int o = 8; o >= 1; o >>= 1) sm += __shfl_xor(sm, o, 64);
      const float mu = sm * (1.f / 64.f);
      const float d0 = y0 - mu, d1 = y1 - mu, d2 = y2 - mu, d3 = y3 - mu;
      float vs = d0 * d0 + d1 * d1 + d2 * d2 + d3 * d3;
#pragma unroll
      for (int o = 8; o >= 1; o >>= 1) vs += __shfl_xor(vs, o, 64);
      const float rs = rsqrtf(vs * (1.f / 64.f) + 64e-5f);
      const float coef = RC[(size_t)row * 4 + (lane >> 4)];
      const uint2 vr = *reinterpret_cast<const uint2*>(RW + (size_t)row * 1536 + 1280 + c);
      const uint2 gr = *reinterpret_cast<const uint2*>(RG + (size_t)row * 256 + c);
      const float o0 = (d0 * rs * lw4.x + lb4.x + coef * lo2f(vr.x)) * lo2f(gr.x);
      const float o1 = (d1 * rs * lw4.y + lb4.y + coef * hi2f(vr.x)) * hi2f(gr.x);
      const float o2 = (d2 * rs * lw4.z + lb4.z + coef * lo2f(vr.y)) * lo2f(gr.y);
      const float o3 = (d3 * rs * lw4.w + lb4.w + coef * hi2f(vr.y)) * hi2f(gr.y);
      uint2 o;
      o.x = pack2(o0, o1);
      o.y = pack2(o2, o3);
      *reinterpret_cast<uint2*>(Y + (size_t)row * 1024 + 256 + c) = o;
    }
  }
}


#define XB_TMO      128
#define XB_XCNT(j)  (256  + 64 * (j))
#define XB_XSUB(j)  (1280 + 64 * (j))
#define XB_XGEN(j)  (2304 + 64 * (j))
#define XB_TOP      3328
#define XB_TOPGEN   3392
#define XCD_BAR_WORDS 3456
#define XB_SPIN_CAP (1u << 20)
#define LAS __attribute__((address_space(3)))
__device__ __forceinline__ unsigned xb_ld(unsigned* p) { return __hip_atomic_load(p, __ATOMIC_RELAXED, __HIP_MEMORY_SCOPE_AGENT); }
__device__ __forceinline__ unsigned xb_add(unsigned* p, unsigned v) { return __hip_atomic_fetch_add(p, v, __ATOMIC_RELAXED, __HIP_MEMORY_SCOPE_AGENT); }
__device__ __forceinline__ unsigned xb_xcc_id() { return (unsigned)__builtin_amdgcn_s_getreg((3 << 11) | 20) & 0xFu; }
#define XB_SPIN(cond, bar) do { unsigned _sp = 0; while (cond) { __builtin_amdgcn_s_sleep(1); \
    if ((++_sp & 255u) == 0u) { if (xb_ld(&(bar)[XB_TMO])) break; if (_sp > XB_SPIN_CAP) { atomicAdd(&(bar)[XB_TMO], 1u); break; } } } } while (0)
struct XcdBarrier { unsigned* bar; unsigned x; volatile LAS unsigned* st; };
__device__ __forceinline__ XcdBarrier xcd_barrier_post(unsigned* bar, volatile LAS unsigned* st) {
  XcdBarrier b; b.bar = bar; b.x = xb_xcc_id(); b.st = st;
  if (threadIdx.x == 0) (void)xb_add(&bar[XB_XCNT(b.x)], 1u);
  return b;
}
__device__ __forceinline__ void xcd_barrier_complete(unsigned* bar, unsigned x, unsigned& nloc, unsigned& nx) {
  const unsigned G = gridDim.x * gridDim.y * gridDim.z;
  unsigned sum, cnt, mine, sp = 0u;
  for (;;) {
    sum = 0u; cnt = 0u; mine = 0u;
#pragma unroll
    for (unsigned j = 0; j < 16; ++j) { const unsigned c = xb_ld(&bar[XB_XCNT(j)]); sum += c; cnt += (c > 0u) ? 1u : 0u; mine = (j == x) ? c : mine; }
    if (sum == G) break;
    __builtin_amdgcn_s_sleep(1);
    if ((++sp & 255u) == 0u) { if (xb_ld(&bar[XB_TMO])) break; if (sp > XB_SPIN_CAP) { atomicAdd(&bar[XB_TMO], 1u); break; } }
  }
  nloc = mine > 0u ? mine : 1u; nx = cnt > 0u ? cnt : 1u;
}
__device__ __forceinline__ void xcd_barrier(const XcdBarrier& b) {
  asm volatile("s_waitcnt vmcnt(0)" ::: "memory");
  __syncthreads();
  if (threadIdx.x == 0) {
    unsigned* bar = b.bar;
    __builtin_amdgcn_s_waitcnt(0);
    unsigned nloc = b.st[0], nx = b.st[1];
    if (nloc == 0u) { xcd_barrier_complete(bar, b.x, nloc, nx); b.st[0] = nloc; b.st[1] = nx; }
    const unsigned old = xb_add(&bar[XB_XSUB(b.x)], 1u);
    const unsigned gen = old / nloc;
    if (old + 1u == (gen + 1u) * nloc) {
      __builtin_amdgcn_fence(__ATOMIC_RELEASE, "agent");
      asm volatile("s_waitcnt vmcnt(0)" ::: "memory");
      const unsigned og = xb_add(&bar[XB_TOP], 1u);
      const unsigned tg = og / nx;
      if (og + 1u == (tg + 1u) * nx) xb_add(&bar[XB_TOPGEN], 1u);
      else XB_SPIN(xb_ld(&bar[XB_TOPGEN]) == tg, bar);
      __builtin_amdgcn_fence(__ATOMIC_ACQUIRE, "agent");
      xb_add(&bar[XB_XGEN(b.x)], 1u);
      asm volatile("s_waitcnt vmcnt(0)" ::: "memory");
    } else {
      XB_SPIN(xb_ld(&bar[XB_XGEN(b.x)]) == gen, bar);
      __builtin_amdgcn_fence(__ATOMIC_ACQUIRE, "agent");
      asm volatile("s_waitcnt vmcnt(0)" ::: "memory");
    }
  }
  __syncthreads();
}

constexpr int NPH = NL * 9 + 1;
#ifndef SCAN_REP
#define SCAN_REP 0
#endif
#ifndef PH_MASK
#define PH_MASK 0x3ff
#endif

__device__ __forceinline__ void run_phase(CP p, int ph, char* smem_full) {
  const int l = ph / 9, s = ph % 9;
  const int vb = bidx(), NVB = nvb();
  char* smem = smem_full + half_id() * 65536;
  bf16_t* WA = (bf16_t*)(p.ws + WS_WA);
  bf16_t* WB = (bf16_t*)(p.ws + WS_WB);
  bf16_t* WO = (bf16_t*)(p.ws + WS_WO);
  bf16_t* PROJ = (bf16_t*)(p.ws + WS_PROJ);
  bf16_t* Yb = (bf16_t*)(p.ws + WS_Y);
  float* TMP = (float*)(p.ws + WS_TMP);
  if (ph == NPH - 1) {
    rowwise_phase(p, 1, p.in[5] + (NL - 1) * D, nullptr, false, DFF / 256);
    return;
  }
  if (!((PH_MASK >> s) & 1)) return;
  switch (s) {
    case 0: {
      if (l == 0) {
        float2* rope = (float2*)(p.ws + WS_ROPE);
        for (int i = vb * 256 + tidx(); i < T * 16; i += NVB * 256) {
          const int t = i >> 4, f = i & 15;
          const float freq = powf(10000.f, -(float)f / 16.f);
          const float ang = (float)t * freq;
          rope[i] = make_float2(cosf(ang), sinf(ang));
        }
        rowwise_phase(p, 0, nullptr, p.in[2], true, 0);
      } else {
        rowwise_phase(p, 1, p.in[5] + (l - 1) * D, p.in[2] + l * D, true, DFF / 256);
      }
      conv_matrix(p.in[6] + (size_t)l * D * MIXIN, WA, D, MIXIN, NIN_PAD, 0, smem, vb, NVB);
      for (int id = NVB - 1 - vb; id < 24; id += NVB) {
        if (id < 4) conv_tile(p.in[16] + (size_t)l * 64 * 256, (bf16_t*)(p.ws + WS_W2T), 64, 256, 0, id * 64, 0, smem);
        else if (id < 8) conv_tile(p.in[18] + (size_t)l * 64 * 256, (bf16_t*)(p.ws + WS_A2T), 64, 256, 0, (id - 4) * 64, 0, smem);
        else if (id < 16) conv_tile(p.in[19] + (size_t)l * 128 * 256, (bf16_t*)(p.ws + WS_G2T), 128, 256, ((id - 8) & 1) * 64, ((id - 8) >> 1) * 64, 0, smem);
        else if (id < 20) conv_tile(p.in[27] + (size_t)l * 16384 + (size_t)(id - 16) * 4096, (bf16_t*)(p.ws + WS_WAT) + (id - 16) * 4096, 64, 64, 0, 0, 0, smem);
        else conv_tile(p.in[29] + (size_t)l * 16384 + (size_t)(id - 20) * 4096, (bf16_t*)(p.ws + WS_WXT) + (id - 20) * 4096, 64, 64, 0, 0, 0, smem);
      }
    } break;
    case 1: gemm_phase256<EPI_BF16>(Yb, WA, D, 14, smem_full, PROJ, PJ, MIXIN); break;
    case 2: {
      for (int u = vb; u < NB * 129; u += NVB) prep_unit(p, l, u, smem);
    } break;
    case 3: {
      for (int u = vb; u < 320; u += NVB) {
        if (u < 128) { for (int rr_ = 0; rr_ < ((SCAN_REP >> 0) & 1) + 1; ++rr_) rwkv_scan_unit(p, u, smem); }
        else if (u < 256) { for (int rr_ = 0; rr_ < ((SCAN_REP >> 1) & 1) + 1; ++rr_) ssd_scan_unit(p, l, u - 128, smem); }
        else if (u < 272) ret_mfma_unit(p, l, u - 256, smem);
        else if (u < 288) { }
        else if (u < 320) { for (int rr_ = 0; rr_ < ((SCAN_REP >> 3) & 1) + 1; ++rr_) lru_scan_unit(p, u - 288, smem); }
      }
      {
        const int nwork = NVB > 320 ? NVB - 320 : NVB;
        const int wk = NVB > 320 ? vb - 320 : vb;
        const int ngu = 16 * 44;
        if (wk >= 0) {
          for (int id = wk; id < 256 + 2 * ngu + 44 * 16; id += nwork) {
            if (id < 256) conv_tile(p.in[7] + (size_t)l * D * D, WO, D, D, (id % 16) * 64, (id / 16) * 64, 0, smem);
            else if (id < 256 + ngu) { const int k = id - 256; conv_tile(p.in[33] + (size_t)l * D * DFF, WA, D, DFF, (k % 16) * 64, (k / 16) * 64, 1, smem); }
            else if (id < 256 + 2 * ngu) { const int k = id - 256 - ngu; conv_tile(p.in[34] + (size_t)l * D * DFF, WA, D, DFF, (k % 16) * 64, (k / 16) * 64, 2, smem); }
            else { const int k = id - 256 - 2 * ngu; conv_tile(p.in[35] + (size_t)l * DFF * D, WB, DFF, D, (k % 44) * 64, (k / 44) * 64, 0, smem); }
          }
        }
      }
    } break;
    case 4: epi_phase(p, l); break;
    case 5: gemm_phase_n1024<D>(p, Yb, WO, smem_full, TMP); break;
    case 8: gemm_phase_n1024<DFF>(p, PROJ, WB, smem_full, TMP); break;
    case 6: rowwise_phase(p, 1, p.in[3] + l * D, p.in[4] + l * D, true, D / 256); break;
    case 7: gemm_phase256<EPI_GLU>(Yb, WA, D, 22, smem_full, PROJ, DFF, DFF); break;
  }
}

#ifndef SCAN_REP
#define SCAN_REP 0
#endif
#ifndef REPEAT_MASK
#define REPEAT_MASK 0
#endif
__global__ void __launch_bounds__(512) hybrid_trunk_kernel(Params p, int ph_lo, int ph_hi) {
  __shared__ __attribute__((aligned(16))) char smem[131072 + 16];
  cg::grid_group grid = cg::this_grid();
#if MULTI_LAUNCH
  for (int ph = ph_lo; ph < ph_hi; ++ph) {
    run_phase(*(const __attribute__((address_space(4))) Params*)__builtin_amdgcn_kernarg_segment_ptr(), ph, smem);
    if (ph + 1 < ph_hi) grid.sync();
  }
#else
  volatile LAS unsigned* stw = (volatile LAS unsigned*)(smem + 131072);
  if (threadIdx.x < 4) stw[threadIdx.x] = 0u;
  __syncthreads();
  XcdBarrier xb = xcd_barrier_post((unsigned*)(p.ws + WS_BAR), stw);
  if (ph_hi < 0) grid.sync();
  for (int ph = ph_lo; ph < ph_hi; ++ph) {
    const int nrep = (REPEAT_MASK != 0 && ph < NPH - 1 && ((REPEAT_MASK >> (ph % 9)) & 1)) ? 2 : 1;
    for (int r = 0; r < nrep; ++r) {
      {
        const __attribute__((address_space(4))) Params* pp = (const __attribute__((address_space(4))) Params*)__builtin_amdgcn_kernarg_segment_ptr();
        asm volatile("" : "+s"(pp));
        run_phase(*pp, ph, smem);
      }
      if (r + 1 < nrep || ph + 1 < ph_hi) xcd_barrier(xb);
    }
  }
#endif
}

extern "C" void kernel_launch(void* const* d_in, const int* in_sizes, int n_in, void* d_out, int out_size, void* d_ws,
                              size_t ws_size, hipStream_t stream) {
  static int grid_blocks = 0;
  if (!grid_blocks) {
    int dev = 0, cus = 0, per_cu = 0;
    hipGetDevice(&dev);
    hipDeviceGetAttribute(&cus, hipDeviceAttributeMultiprocessorCount, dev);
    hipOccupancyMaxActiveBlocksPerMultiprocessor(&per_cu, hybrid_trunk_kernel, 512, 0);
    if (per_cu > 1) per_cu = 1;
    if (per_cu < 1) per_cu = 1;
    grid_blocks = cus * per_cu;
  }
  if (ws_size < WS_TOTAL || n_in < 36) {
    fprintf(stderr, "workspace too small: %zu < %zu\n", ws_size, (size_t)WS_END);
    return;
  }
  Params p{};
  for (int i = 0; i < 36; ++i) p.in[i] = (const float*)d_in[i];
  p.out = (float*)d_out;
  p.ws = (char*)d_ws;
#if MULTI_LAUNCH
  for (int ph = 0; ph < NPH; ++ph) {
    hipLaunchKernelGGL(hybrid_trunk_kernel, dim3(grid_blocks), dim3(512), 0, stream, p, ph, ph + 1);
  }
#else
  hipMemsetAsync((char*)d_ws + WS_BAR, 0, XCD_BAR_WORDS * 4, stream);
  int lo = 0, hi = NPH;
  void* args[] = {&p, &lo, &hi};
  hipError_t e = hipLaunchCooperativeKernel((void*)hybrid_trunk_kernel, dim3(grid_blocks), dim3(512), args, 0, stream);
  if (e != hipSuccess) fprintf(stderr, "cooperative launch failed: %s (grid %d)\n", hipGetErrorString(e), grid_blocks);
#endif
}
```
